# Optimizing an MI355X kernel written in HIP

```python
import jax, jax.numpy as jnp
from jax import lax
import numpy as np

D_MODEL = 1024
BATCH = 16
SEQ = 2048
DEPTH = 1
DEC_BATCH = 16
DEC_SEQ = 64
PAST_LEN = 4096

CHUNK = 64
D_MIX = D_MODEL
D_CONV = D_MIX // 2
CONV_WIDTH = 31
HG_HEADS = 4
HG_DK = (D_MIX - D_CONV) // HG_HEADS
HG_DV = HG_DK
D_HG = HG_HEADS * HG_DK
D_IN = 2 * D_CONV + 4 * D_HG
D_FF = 2816
EPS = 1e-6

kernel_name = "conformer_conv_hgrn2_hybrid_step"


def _rmsnorm(x, g):
    xf = x.astype(jnp.float32)
    y = xf * lax.rsqrt(jnp.mean(xf * xf, axis=-1, keepdims=True) + EPS)
    return (y * g.astype(jnp.float32)).astype(x.dtype)


def _layernorm(x, g, b):
    xf = x.astype(jnp.float32)
    mu = jnp.mean(xf, axis=-1, keepdims=True)
    var = jnp.mean(jnp.square(xf - mu), axis=-1, keepdims=True)
    y = (xf - mu) * lax.rsqrt(var + EPS)
    return (y * g.astype(jnp.float32) + b.astype(jnp.float32)).astype(x.dtype)


def _swiglu(h, w1, w3, w2):
    return (jax.nn.silu(h @ w1) * (h @ w3)) @ w2


def _conv_module(u, buf, dw_w, dw_b, ln_g, ln_b):
    xp = jnp.concatenate([buf.astype(u.dtype), u], axis=1)
    y = lax.conv_general_dilated(
        xp, dw_w[:, None, :].astype(u.dtype), window_strides=(1,), padding='VALID',
        dimension_numbers=('NWC', 'WIO', 'NWC'), feature_group_count=D_CONV)
    y = y + dw_b.astype(u.dtype)
    y = jax.nn.silu(_layernorm(y, ln_g, ln_b))
    return y, xp[:, -(CONV_WIDTH - 1):]


def _chunk_scan(q, k, logf, v, s0):
    B, T, H, DK = q.shape
    L = min(CHUNK, T)
    n = T // L

    def split(a):
        return a.reshape(B, n, L, *a.shape[2:]).swapaxes(0, 1)

    causal = jnp.tril(jnp.ones((L, L), dtype=bool))[None, :, :, None, None]

    def step(S, inp):
        qc, kc, fc, vc = inp
        b = jnp.cumsum(fc, axis=1)
        diff = b[:, :, None] - b[:, None, :]
        decay = jnp.exp(jnp.where(causal, diff, -jnp.inf))
        A = jnp.einsum('bthk,bshk,btshk->bhts', qc, kc, decay)
        o = jnp.einsum('bhts,bshv->bthv', A, vc) + jnp.einsum('bthk,bhkv->bthv', qc * jnp.exp(b), S)
        bl = b[:, -1]
        S_new = jnp.exp(bl)[..., None] * S + jnp.einsum('bshk,bshv->bhkv', kc * jnp.exp(bl[:, None] - b), vc)
        return S_new, o

    S, o = lax.scan(step, s0, (split(q), split(k), split(logf), split(v)))
    o = o.swapaxes(0, 1).reshape(B, T, H, v.shape[-1])
    return o, S


def _hgrn2(q_raw, f_raw, i_raw, g_raw, s0, lb, gn):
    B, T, _ = q_raw.shape
    f32 = jnp.float32
    q = jax.nn.silu(q_raw.astype(f32)).reshape(B, T, HG_HEADS, HG_DK)
    fr = f_raw.astype(f32).reshape(B, T, HG_HEADS, HG_DK)
    lbh = lb.reshape(HG_HEADS, HG_DK)
    logf = jnp.log(lbh + (1.0 - lbh) * jax.nn.sigmoid(fr))
    k = (1.0 - lbh) * jax.nn.sigmoid(-fr)
    v = i_raw.astype(f32).reshape(B, T, HG_HEADS, HG_DV)
    o, S = _chunk_scan(q, k, logf, v, s0.astype(f32))
    o = o * lax.rsqrt(jnp.mean(o * o, axis=-1, keepdims=True) + EPS)
    o = o.reshape(B, T, D_HG) * gn.astype(f32) * jax.nn.silu(g_raw.astype(f32))
    return o.astype(q_raw.dtype), S


def _layer(x, conv_buf, s0, lb, n1, f1a, f1b, f1c, nm, w_in, dw_w, dw_b, ln_g, ln_b, gn, w_out, n2, f2a, f2b, f2c):
    x = x + 0.5 * _swiglu(_rmsnorm(x, n1), f1a, f1b, f1c)
    h = _rmsnorm(x, nm)
    p = h @ w_in
    a, gt, qr, fr, ir, gr = jnp.split(
        p, [D_CONV, 2 * D_CONV, 2 * D_CONV + D_HG, 2 * D_CONV + 2 * D_HG, 2 * D_CONV + 3 * D_HG], axis=-1)
    u = a * jax.nn.sigmoid(gt)
    c, new_buf = _conv_module(u, conv_buf, dw_w, dw_b, ln_g, ln_b)
    r, S = _hgrn2(qr, fr, ir, gr, s0, lb, gn)
    x = x + jnp.concatenate([c, r], axis=-1) @ w_out
    x = x + 0.5 * _swiglu(_rmsnorm(x, n2), f2a, f2b, f2c)
    return x, new_buf, S


def setup_inputs(seed: int = 0) -> dict:
    key = jax.random.key(seed)
    ks = jax.random.split(key, 24)
    f32 = jnp.float32

    def nrm(k, shape, scale):
        return jax.random.normal(k, shape, f32) * scale

    def gain(k, shape):
        return 1.0 + 0.02 * jax.random.normal(k, shape, f32)

    return {
        "x_prompt": nrm(ks[0], (BATCH, SEQ, D_MODEL), 1.0),
        "x_sample": nrm(ks[1], (DEC_BATCH, DEC_SEQ, D_MODEL), 1.0),
        "state_conv": nrm(ks[2], (DEPTH, DEC_BATCH, CONV_WIDTH - 1, D_CONV), 0.5),
        "state_hgrn": nrm(ks[3], (DEPTH, DEC_BATCH, HG_HEADS, HG_DK, HG_DV), 0.3),
        "ffn1_norm": gain(ks[4], (DEPTH, D_MODEL)),
        "ffn1_w1": nrm(ks[5], (DEPTH, D_MODEL, D_FF), D_MODEL ** -0.5),
        "ffn1_w3": nrm(ks[6], (DEPTH, D_MODEL, D_FF), D_MODEL ** -0.5),
        "ffn1_w2": nrm(ks[7], (DEPTH, D_FF, D_MODEL), D_FF ** -0.5),
        "mix_norm": gain(ks[8], (DEPTH, D_MODEL)),
        "w_in": nrm(ks[9], (DEPTH, D_MODEL, D_IN), D_MODEL ** -0.5),
        "conv_dw_w": nrm(ks[10], (DEPTH, CONV_WIDTH, D_CONV), CONV_WIDTH ** -0.5),
        "conv_dw_b": nrm(ks[11], (DEPTH, D_CONV), 0.02),
        "conv_ln_g": gain(ks[12], (DEPTH, D_CONV)),
        "conv_ln_b": nrm(ks[13], (DEPTH, D_CONV), 0.02),
        "hg_lb_logits": nrm(ks[14], (DEPTH + 1, D_HG), 0.1),
        "hg_gnorm": gain(ks[15], (DEPTH, D_HG)),
        "w_out": nrm(ks[16], (DEPTH, D_MIX, D_MODEL), D_MIX ** -0.5),
        "ffn2_norm": gain(ks[17], (DEPTH, D_MODEL)),
        "ffn2_w1": nrm(ks[18], (DEPTH, D_MODEL, D_FF), D_MODEL ** -0.5),
        "ffn2_w3": nrm(ks[19], (DEPTH, D_MODEL, D_FF), D_MODEL ** -0.5),
        "ffn2_w2": nrm(ks[20], (DEPTH, D_FF, D_MODEL), D_FF ** -0.5),
        "final_norm": gain(ks[21], (D_MODEL,)),
    }


def reference(x_prompt, x_sample, state_conv, state_hgrn, ffn1_norm, ffn1_w1, ffn1_w3, ffn1_w2,
              mix_norm, w_in, conv_dw_w, conv_dw_b, conv_ln_g, conv_ln_b, hg_lb_logits, hg_gnorm,
              w_out, ffn2_norm, ffn2_w1, ffn2_w3, ffn2_w2, final_norm):
    lb_all = jnp.cumsum(jax.nn.softmax(hg_lb_logits.astype(jnp.float32), axis=0), axis=0)
    yp, ys = x_prompt, x_sample
    conv_p, hgrn_p, conv_s, hgrn_s = [], [], [], []
    for l in range(DEPTH):
        lw = (ffn1_norm[l], ffn1_w1[l], ffn1_w3[l], ffn1_w2[l], mix_norm[l], w_in[l],
              conv_dw_w[l], conv_dw_b[l], conv_ln_g[l], conv_ln_b[l], hg_gnorm[l], w_out[l],
              ffn2_norm[l], ffn2_w1[l], ffn2_w3[l], ffn2_w2[l])
        buf0 = jnp.zeros((x_prompt.shape[0], CONV_WIDTH - 1, D_CONV), x_prompt.dtype)
        s00 = jnp.zeros((x_prompt.shape[0], HG_HEADS, HG_DK, HG_DV), jnp.float32)
        yp, bp, sp = _layer(yp, buf0, s00, lb_all[l], *lw)
        ys, bs, ss = _layer(ys, state_conv[l], state_hgrn[l], lb_all[l], *lw)
        conv_p.append(bp.astype(state_conv.dtype))
        hgrn_p.append(sp.astype(state_hgrn.dtype))
        conv_s.append(bs.astype(state_conv.dtype))
        hgrn_s.append(ss.astype(state_hgrn.dtype))
    y_prompt = _rmsnorm(yp, final_norm)
    y_sample = _rmsnorm(ys, final_norm)
    new_conv_prompt = jnp.stack(conv_p, axis=0)
    new_hgrn_prompt = jnp.stack(hgrn_p, axis=0)
    new_conv_sample = jnp.stack(conv_s, axis=0)
    new_hgrn_sample = jnp.stack(hgrn_s, axis=0)
    return (y_prompt, y_sample, new_conv_prompt, new_hgrn_prompt, new_conv_sample, new_hgrn_sample)
```

```cpp
#include <hip/hip_runtime.h>
#include <hip/hip_cooperative_groups.h>
#include <cstdio>
#include <cstdint>
namespace cg = cooperative_groups;
#ifndef MK_XABASE
#define MK_XABASE 1
#endif
#ifndef MK_DUP
#define MK_DUP -1
#endif

#define LAS __attribute__((address_space(3)))
typedef unsigned short bf16_t;
typedef short bf16x8 __attribute__((ext_vector_type(8)));
typedef float f32x4 __attribute__((ext_vector_type(4)));
typedef unsigned u32x4 __attribute__((ext_vector_type(4)));
typedef unsigned u32x2 __attribute__((ext_vector_type(2)));

__device__ __forceinline__ unsigned cvt_pk_bf16(float lo, float hi) { unsigned r; asm volatile("v_cvt_pk_bf16_f32 %0, %1, %2" : "=v"(r) : "v"(lo), "v"(hi)); return r; }
__device__ __forceinline__ float bf2f(unsigned h) { return __uint_as_float(h << 16); }
__device__ __forceinline__ float bflo(unsigned w) { return __uint_as_float(w << 16); }
__device__ __forceinline__ float bfhi(unsigned w) { return __uint_as_float(w & 0xffff0000u); }
__device__ __forceinline__ float sigmoidf_(float x) { return __builtin_amdgcn_rcpf(1.0f + __expf(-x)); }
__device__ __forceinline__ float siluf_(float x) { return x * sigmoidf_(x); }
__device__ __forceinline__ float ss_row(const float* ssb, size_t row, int q, int stride) {
    const f32x4 v = *(const f32x4*)(ssb + row * 16 + 4 * q);
    float s = (v.x + v.y) + (v.z + v.w);
    s += __shfl_xor(s, stride); s += __shfl_xor(s, 2 * stride);
    return s;
}
__device__ __forceinline__ void rs_rows(const float* ssb, int row0, int fq, float (&rs)[8]) {
    f32x4 v[8];
#pragma unroll
    for (int i = 0; i < 8; ++i) v[i] = *(const f32x4*)(ssb + (size_t)(row0 + (i >> 2) * 128 + (i & 3) * 16) * 16 + 4 * fq);
#pragma unroll
    for (int i = 0; i < 8; ++i) { float s = (v[i].x + v[i].y) + (v[i].z + v[i].w); s += __shfl_xor(s, 16); s += __shfl_xor(s, 32); rs[i] = __builtin_amdgcn_rsqf(s * (1.0f / 1024.0f) + 1e-6f); }
}
#define LBAR() do { asm volatile("s_waitcnt lgkmcnt(0)" ::: "memory"); __builtin_amdgcn_s_barrier(); asm volatile("" ::: "memory"); } while (0)

constexpr int MP = 32768, MS = 1024, MTOK = MP + MS, DM = 1024, FF = 2816, DIN = 3072, DC = 512, DH = 512;
constexpr int TP = 2048, TS = 64, NB = 16, CW = 31;
constexpr float EPS = 1e-6f;
constexpr size_t MiB = 1u << 20;
constexpr size_t WS_SS = 424 * MiB;
constexpr size_t WS_W13A = 2 * MiB, WS_W2A = 13 * MiB, WS_WIN = 19 * MiB, WS_WOUT = 25 * MiB, WS_W13B = 27 * MiB, WS_W2B = 38 * MiB;
constexpr size_t WS_XA = 44 * MiB, WS_H = 110 * MiB;
constexpr size_t WS_U = 110 * MiB, WS_Q = 143 * MiB, WS_K = 176 * MiB, WS_V = 209 * MiB, WS_G = 242 * MiB, WS_LF = 292 * MiB, WS_CR = 358 * MiB, WS_BAR = 434 * MiB, WS_END = 435 * MiB;
constexpr size_t OY = 0, OCP = (size_t)MTOK * DM, OHP = OCP + 16 * 30 * 512, OCS = OHP + 16 * 4 * 128 * 128, OHS = OCS + 16 * 30 * 512;
constexpr int LDS_BYTES = 147456;

struct Args { const float* in[22]; float* out; unsigned char* ws; int ph_lo, ph_hi; };
enum { I_XP = 0, I_XS, I_SCONV, I_SHGRN, I_N1, I_F1W1, I_F1W3, I_F1W2, I_NM, I_WIN, I_DWW, I_DWB, I_LNG, I_LNB, I_LOGITS, I_GN, I_WOUT, I_N2, I_F2W1, I_F2W3, I_F2W2, I_NF };

__device__ __forceinline__ unsigned char* ws_reload() {
    typedef unsigned char* ptr_t;
    const __attribute__((address_space(4))) char* ka = (const __attribute__((address_space(4))) char*)__builtin_amdgcn_kernarg_segment_ptr();
    return *(const volatile __attribute__((address_space(4))) ptr_t*)(ka + 22 * 8 + 8);
}

namespace pg8 {
constexpr int BM = 256, BK = 64, HALF = 128, HTB = HALF * BK * 2  , STAGE_BYTES = 8 * HTB, NXCD = 8, WGM = 8;
__host__ __device__ __forceinline__ int lds_byte(int r, int c) { const int st = (r >> 4) * 2 + (c >> 5), rr = r & 15, cc = c & 31, ob = rr * 64 + cc * 2; return st * 1024 + (ob ^ (((ob >> 9) & 1) << 5)); }
__host__ __device__ __forceinline__ void stage_rc(int b, int& R, int& C) { const int st = b / 1024, sb = b % 1024, swz = sb ^ (((sb >> 9) & 1) << 5); R = (st >> 1) * 16 + swz / 64; C = (st & 1) * 32 + (swz % 64) / 2; }
__host__ __device__ __forceinline__ int perm32(int rho) { const int n = rho >> 4, i = rho & 15; return 8 * (i >> 2) + 4 * n + (i & 3); }

struct Unit { int pm, pn; };
struct Gemm { const bf16_t* A; const bf16_t* Bt; int M, N, K; };

struct StaticOrder {
    int nM, nN, nwg, G, c;
    __host__ __device__ void init(int M, int N, int G_, int c_) { nM = M / BM; nN = N / BM; nwg = nM * nN; G = G_; c = c_; }
    __host__ __device__ bool next(int i, Unit& u) const {
        const long L = (long)i * G + c; if (L >= nwg) return false;
        int wgid = (int)L; { const int q = nwg / NXCD, r = nwg % NXCD, xcd = wgid % NXCD, off = wgid / NXCD; wgid = (xcd < r ? xcd * (q + 1) : r * (q + 1) + (xcd - r) * q) + off; }
        const int nig = WGM * nN, gid = wgid / nig, fm = gid * WGM, gsz = (nM - fm) < WGM ? (nM - fm) : WGM;
        u.pm = fm + ((wgid % nig) % gsz); u.pn = (wgid % nig) / gsz; return true;
    }
};

struct Epi { int kind, perm, ph, pn_off, pm_off; };

__device__ __forceinline__ void epi_swiglu(const Args& a, const Epi& E, const f32x4 (&acc)[2][2][4][2], const Unit& u, int wr, int wc, int fr, int fq, const LAS float* rst) {
    unsigned char* const wsl = ws_reload();
    asm volatile("" : "+v"(fr), "+v"(fq));
    const int row0 = u.pm * BM + wr * 64 + fr, col0 = u.pn * HALF + wc * 32 + 8 * fq;
    const float* ss_in = (const float*)(wsl + WS_SS) + (E.ph == 1 ? 0 : 2 * (size_t)MTOK * 16);
    bf16_t* Hh = (bf16_t*)(wsl + WS_H);
    float rs8[8];
#pragma unroll
    for (int i = 0; i < 8; ++i) rs8[i] = rst[(i >> 2) * HALF + wr * 64 + (i & 3) * 16 + fr];
#pragma unroll
    for (int ai = 0; ai < 2; ++ai)
#pragma unroll
        for (int m = 0; m < 4; ++m) {
            const int row = row0 + ai * HALF + m * 16;
            const float rs = rs8[ai * 4 + m];
            float h[8];
#pragma unroll
            for (int n = 0; n < 2; ++n)
#pragma unroll
                for (int j = 0; j < 4; ++j) { const float av = acc[ai][0][m][n][j] * rs, b = acc[ai][1][m][n][j] * rs; h[n * 4 + j] = siluf_(av) * b; }
            u32x4 w; w.x = cvt_pk_bf16(h[0], h[1]); w.y = cvt_pk_bf16(h[2], h[3]); w.z = cvt_pk_bf16(h[4], h[5]); w.w = cvt_pk_bf16(h[6], h[7]);
            *(u32x4*)(Hh + (size_t)row * FF + col0) = w;
        }
}

__device__ __forceinline__ void epi_resid(const Args& a, const Epi& E, const f32x4 (&acc)[2][2][4][2], const Unit& u, int wr, int wc, int fr, int fq) {
    unsigned char* const wsl = ws_reload();
    asm volatile("" : "+v"(fr), "+v"(fq));
    bf16_t* xa = (bf16_t*)(wsl + WS_XA);
    const float* xin = (u.pm < MP / BM) ? a.in[I_XP] + (size_t)u.pm * BM * DM : a.in[I_XS] + (size_t)(u.pm - MP / BM) * BM * DM;
    const float scale = (E.ph == 5) ? 1.0f : 0.5f;
    float* ss_out = (float*)(wsl + WS_SS) + (size_t)(E.ph == 2 ? 1 : (E.ph == 5 ? 2 : 3)) * MTOK * 16;
    const int col0 = u.pn * BM + wc * 32 + 8 * fq;
#pragma unroll
    for (int ai = 0; ai < 2; ++ai) {
        f32x4 bb[4][2][2];
        if (E.ph == 2 && !MK_XABASE) {
#pragma unroll
            for (int m = 0; m < 4; ++m)
#pragma unroll
                for (int bj = 0; bj < 2; ++bj)
#pragma unroll
                    for (int n = 0; n < 2; ++n) bb[m][bj][n] = *(const f32x4*)(xin + (size_t)(ai * HALF + wr * 64 + m * 16 + fr) * DM + col0 + bj * HALF + n * 4);
        } else {
            u32x4 rb[4][2];
#pragma unroll
            for (int m = 0; m < 4; ++m)
#pragma unroll
                for (int bj = 0; bj < 2; ++bj) rb[m][bj] = *(const u32x4*)(xa + ((size_t)u.pm * BM + ai * HALF + wr * 64 + m * 16 + fr) * DM + col0 + bj * HALF);
#pragma unroll
            for (int m = 0; m < 4; ++m)
#pragma unroll
                for (int bj = 0; bj < 2; ++bj) { const u32x4 r = rb[m][bj]; bb[m][bj][0] = (f32x4){bflo(r.x), bfhi(r.x), bflo(r.y), bfhi(r.y)}; bb[m][bj][1] = (f32x4){bflo(r.z), bfhi(r.z), bflo(r.w), bfhi(r.w)}; }
        }
#pragma unroll
        for (int m = 0; m < 4; ++m) {
            const int lr = ai * HALF + wr * 64 + m * 16 + fr; const size_t grow = (size_t)u.pm * BM + lr;
            float s = 0.f;
#pragma unroll
            for (int bj = 0; bj < 2; ++bj) {
                const f32x4 o0 = bb[m][bj][0] + acc[ai][bj][m][0] * scale, o1 = bb[m][bj][1] + acc[ai][bj][m][1] * scale;
                u32x4 w; w.x = cvt_pk_bf16(o0[0], o0[1]); w.y = cvt_pk_bf16(o0[2], o0[3]); w.z = cvt_pk_bf16(o1[0], o1[1]); w.w = cvt_pk_bf16(o1[2], o1[3]);
                *(u32x4*)(xa + grow * DM + col0 + bj * HALF) = w;
                s += ((o0[0] * o0[0] + o0[1] * o0[1]) + (o0[2] * o0[2] + o0[3] * o0[3])) + ((o1[0] * o1[0] + o1[1] * o1[1]) + (o1[2] * o1[2] + o1[3] * o1[3]));
            }
            s += __shfl_xor(s, 16); s += __shfl_xor(s, 32);
            if (fq == 0) ss_out[grow * 16 + u.pn * 4 + wc] = s;
        }
        asm volatile("" ::: "memory");
    }
}

__device__ __forceinline__ void epi_mix(const Args& a, const Epi& E, const f32x4 (&acc)[2][2][4][2], const Unit& u, int wr, int wc, int fr, int fq, const LAS float* rst) {
    unsigned char* const wsl = ws_reload();
    asm volatile("" : "+v"(fr), "+v"(fq));
    const int pmg = u.pm + E.pm_off;
    const int row0 = pmg * BM + wr * 64 + fr;
    const float* ss_in = (const float*)(wsl + WS_SS) + (size_t)MTOK * 16;
    float rs8[8];
#pragma unroll
    for (int i = 0; i < 8; ++i) rs8[i] = rst[(i >> 2) * HALF + wr * 64 + (i & 3) * 16 + fr];
    const int pn = u.pn + E.pn_off;
    if (pn < 4) {
        const int ch0 = pn * HALF + wc * 32 + 8 * fq;
#pragma unroll
        for (int ai = 0; ai < 2; ++ai)
#pragma unroll
            for (int m = 0; m < 4; ++m) {
                const int row = row0 + ai * HALF + m * 16;
                const float rs = rs8[ai * 4 + m];
                float h[8];
#pragma unroll
                for (int n = 0; n < 2; ++n)
#pragma unroll
                    for (int j = 0; j < 4; ++j) { const float a = acc[ai][0][m][n][j] * rs, g = acc[ai][1][m][n][j] * rs; h[n * 4 + j] = a * sigmoidf_(g); }
                u32x4 w; w.x = cvt_pk_bf16(h[0], h[1]); w.y = cvt_pk_bf16(h[2], h[3]); w.z = cvt_pk_bf16(h[4], h[5]); w.w = cvt_pk_bf16(h[6], h[7]);
                *(u32x4*)((bf16_t*)(wsl + WS_U) + (size_t)row * DC + ch0) = w;
                const bool samp = pmg >= MP / BM;
                const int r2 = samp ? row - MP : row, sh = samp ? 6 : 11, T = samp ? TS : TP, seq = r2 >> sh, t = r2 & (T - 1);
                const size_t obase = samp ? OCS : OCP;
                if (t >= T - 30) { float* d = a.out + obase + ((size_t)(seq * 30 + (t - (T - 30))) * DC + ch0);
                    *(f32x4*)d = (f32x4){h[0], h[1], h[2], h[3]}; *(f32x4*)(d + 4) = (f32x4){h[4], h[5], h[6], h[7]}; }
                asm volatile("" ::: "memory");
            }
    } else {
        const int typ = (pn - 4) >> 1;
        const size_t dsto = typ == 0 ? WS_Q : typ == 1 ? WS_K : typ == 2 ? WS_V : WS_G;
        bf16_t* dstb = (bf16_t*)(wsl + dsto);
#pragma unroll
        for (int bj = 0; bj < 2; ++bj) {
            const int cc0 = ((pn - 4) & 1) * BM + bj * HALF + wc * 32 + 8 * fq;
            f32x4 aux[2] = {(f32x4){0.f, 0.f, 0.f, 0.f}, (f32x4){0.f, 0.f, 0.f, 0.f}};
            if (typ == 1) {
#pragma unroll
                for (int n = 0; n < 2; ++n) { const f32x4 l0 = *(const f32x4*)(a.in[I_LOGITS] + cc0 + 4 * n), l1 = *(const f32x4*)(a.in[I_LOGITS] + DH + cc0 + 4 * n);
#pragma unroll
                    for (int j = 0; j < 4; ++j) aux[n][j] = sigmoidf_(l0[j] - l1[j]); }
            } else if (typ == 3) { aux[0] = *(const f32x4*)(a.in[I_GN] + cc0); aux[1] = *(const f32x4*)(a.in[I_GN] + cc0 + 4); }
#pragma unroll
            for (int ai = 0; ai < 2; ++ai)
#pragma unroll
                for (int m = 0; m < 4; ++m) {
                    const int row = row0 + ai * HALF + m * 16;
                    const float rs = rs8[ai * 4 + m];
                    u32x4 w;
#pragma unroll
                    for (int n = 0; n < 2; ++n) {
                        const f32x4 v = acc[ai][bj][m][n] * rs;
                        f32x4 h;
                        if (typ == 0) {
#pragma unroll
                            for (int j = 0; j < 4; ++j) h[j] = siluf_(v[j]);
                        } else if (typ == 1) { f32x4 lf;
#pragma unroll
                            for (int j = 0; j < 4; ++j) { const float sg = sigmoidf_(v[j]); lf[j] = __logf(aux[n][j] + (1.0f - aux[n][j]) * sg); h[j] = (1.0f - aux[n][j]) * (1.0f - sg); }
                            *(f32x4*)((float*)(wsl + WS_LF) + (size_t)row * DH + cc0 + 4 * n) = lf;
                        } else if (typ == 2) h = v;
                        else {
#pragma unroll
                            for (int j = 0; j < 4; ++j) h[j] = aux[n][j] * siluf_(v[j]);
                        }
                        if (n == 0) { w.x = cvt_pk_bf16(h[0], h[1]); w.y = cvt_pk_bf16(h[2], h[3]); } else { w.z = cvt_pk_bf16(h[0], h[1]); w.w = cvt_pk_bf16(h[2], h[3]); }
                    }
                    *(u32x4*)(dstb + (size_t)row * DH + cc0) = w;
                    asm volatile("" ::: "memory");
                }
        }
    }
}

__device__ __forceinline__ void gemm_phase(const Args& a, LAS unsigned char* lds, const Gemm g, const StaticOrder& S, const Epi& E, const int wid0) {
    int tid = wid0 * 64 + (int)__builtin_amdgcn_mbcnt_hi(~0u, __builtin_amdgcn_mbcnt_lo(~0u, 0u)); asm volatile("" : "+v"(tid));
    const int wid = __builtin_amdgcn_readfirstlane(tid >> 6), lane = tid & 63, wr = wid >> 2, wc = wid & 3, fr = lane & 15, fq = lane >> 4;
    const int K = g.K, nt = K / BK;
    unsigned voffA[2], voffB[2];
#pragma unroll
    for (int i = 0; i < 2; ++i) { int R, C; stage_rc(tid * 16 + i * 8192, R, C); const int Rb = E.perm ? ((R & ~31) + perm32(R & 31)) : R;
        voffA[i] = (unsigned)(R * K + C) * 2u; voffB[i] = (unsigned)(Rb * K + C) * 2u; }
    const size_t kstep = (size_t)(BK * 2);
    const size_t hstep = (size_t)HALF * K * 2;
    const size_t tstep = 2 * hstep;
    const unsigned ldsw = (unsigned)wid * 1024u;
    const int aoff = lds_byte(wr * 64 + fr, fq * 8), boff = lds_byte(wc * 32 + fr, fq * 8);
#define PG8_SA(b, h) (((b) * 2 + (h)) * HTB)
#define PG8_SB(b, h) ((4 + (b) * 2 + (h)) * HTB)
#define PG8_STAGE(bufoff, gbase, voff) do { _Pragma("unroll") for (int _i = 0; _i < 2; ++_i) \
        __builtin_amdgcn_global_load_lds((const unsigned*)((const char*)(gbase) + (voff)[_i]), (LAS unsigned*)(lds + (bufoff) + ldsw + _i * 8192), 16, 0, 0); } while (0)
#define PG8_LDA(dst, b, h) do { _Pragma("unroll") for (int m = 0; m < 4; ++m) _Pragma("unroll") for (int k = 0; k < 2; ++k) dst[m][k] = *(const LAS bf16x8*)(lds + PG8_SA(b, h) + aoff + m * 2048 + k * 1024); } while (0)
#define PG8_LDB(dst, b, h) do { _Pragma("unroll") for (int n = 0; n < 2; ++n) _Pragma("unroll") for (int k = 0; k < 2; ++k) dst[n][k] = *(const LAS bf16x8*)(lds + PG8_SB(b, h) + boff + n * 2048 + k * 1024); } while (0)
#define PG8_MMA(ai, bj, At, Bt) do { __builtin_amdgcn_s_setprio(1); _Pragma("unroll") for (int m = 0; m < 4; ++m) _Pragma("unroll") for (int n = 0; n < 2; ++n) _Pragma("unroll") for (int k = 0; k < 2; ++k) \
        acc[ai][bj][m][n] = __builtin_amdgcn_mfma_f32_16x16x32_bf16(Bt[n][k], At[m][k], acc[ai][bj][m][n], 0, 0, 0); __builtin_amdgcn_s_setprio(0); } while (0)
#define PG8_WAIT_V(n) asm volatile("s_waitcnt vmcnt(" #n ")" ::: "memory")
#define PG8_WAIT_L(n) asm volatile("s_waitcnt lgkmcnt(" #n ")" ::: "memory")
#define PG8_BAR __builtin_amdgcn_s_barrier()
#define PG8_SCHED __builtin_amdgcn_sched_barrier(0)
    Unit cur, nxt; int ui = 0;
    if (!S.next(0, cur)) return;
    LAS float* rstab = (LAS float*)(lds + STAGE_BYTES);
    if (E.kind != 1) {
        const float* ssb = (const float*)(ws_reload() + WS_SS) + (E.kind == 2 ? (size_t)MTOK * 16 : (E.ph == 1 ? 0 : 2 * (size_t)MTOK * 16));
        for (int j = tid; ; j += 512) { Unit uu; if (!S.next(j >> 8, uu)) break;
            const f32x4* p = (const f32x4*)(ssb + ((size_t)(uu.pm + (E.kind == 2 ? E.pm_off : 0)) * BM + (j & 255)) * 16); const f32x4 x0 = p[0], x1 = p[1], x2 = p[2], x3 = p[3];
            const float s = (((x0.x + x0.y) + (x0.z + x0.w)) + ((x1.x + x1.y) + (x1.z + x1.w))) + (((x2.x + x2.y) + (x2.z + x2.w)) + ((x3.x + x3.y) + (x3.z + x3.w)));
            rstab[j] = __builtin_amdgcn_rsqf(s * (1.0f / 1024.0f) + 1e-6f); }
        asm volatile("s_waitcnt vmcnt(0) lgkmcnt(0)" ::: "memory"); __builtin_amdgcn_s_barrier(); asm volatile("" ::: "memory");
    }
    f32x4 acc[2][2][4][2];
#pragma unroll
    for (int a = 0; a < 2; ++a)
#pragma unroll
        for (int b = 0; b < 2; ++b)
#pragma unroll
            for (int m = 0; m < 4; ++m)
#pragma unroll
                for (int n = 0; n < 2; ++n) acc[a][b][m][n] = (f32x4){0.f, 0.f, 0.f, 0.f};
    bf16x8 At[4][2], B0[2][2], B1[2][2];
    const char* cA = (const char*)g.A + (size_t)cur.pm * tstep; const char* cB = (const char*)g.Bt + (size_t)cur.pn * tstep;
    PG8_STAGE(PG8_SB(0, 0), cB, voffB); PG8_STAGE(PG8_SB(0, 1), cB + hstep, voffB); PG8_STAGE(PG8_SA(0, 0), cA, voffA); PG8_STAGE(PG8_SA(0, 1), cA + hstep, voffA);
    if (wr == 1) PG8_BAR;
    PG8_WAIT_V(2); PG8_BAR;
    PG8_STAGE(PG8_SB(1, 0), cB + kstep, voffB); PG8_STAGE(PG8_SA(1, 0), cA + kstep, voffA); PG8_STAGE(PG8_SB(1, 1), cB + hstep + kstep, voffB);
    PG8_WAIT_V(6); PG8_BAR;
    for (;;) {
        const bool has_next = S.next(ui + 1, nxt);
        const char* nA = has_next ? (const char*)g.A + (size_t)nxt.pm * tstep : cA; const char* nB = has_next ? (const char*)g.Bt + (size_t)nxt.pn * tstep : cB;
        for (int t = 0; t < nt; t += 2) {
            const bool last = (t == nt - 2);
            const char* a1 = cA + (size_t)(t + 1) * kstep;
            const char* a2 = last ? nA : cA + (size_t)(t + 2) * kstep; const char* b2 = last ? nB : cB + (size_t)(t + 2) * kstep;
            const char* a3 = a2 + kstep; const char* b3 = b2 + kstep;
            PG8_LDB(B0, 0, 0); PG8_LDB(B1, 0, 1); PG8_SCHED; PG8_LDA(At, 0, 0); PG8_STAGE(PG8_SA(1, 1), a1 + hstep, voffA);
            PG8_WAIT_V(8); PG8_WAIT_L(0); PG8_BAR; PG8_MMA(0, 0, At, B0); PG8_MMA(0, 1, At, B1); PG8_BAR; PG8_SCHED;
            PG8_LDA(At, 0, 1); PG8_STAGE(PG8_SB(0, 0), b2, voffB); PG8_STAGE(PG8_SB(0, 1), b2 + hstep, voffB); PG8_STAGE(PG8_SA(0, 0), a2, voffA);
            PG8_WAIT_V(8); PG8_WAIT_L(0); PG8_BAR; PG8_MMA(1, 0, At, B0); PG8_MMA(1, 1, At, B1); PG8_BAR; PG8_SCHED;
            PG8_LDB(B0, 1, 0); PG8_LDB(B1, 1, 1); PG8_SCHED; PG8_LDA(At, 1, 0); PG8_STAGE(PG8_SA(0, 1), a2 + hstep, voffA);
            PG8_WAIT_V(8); PG8_WAIT_L(0); PG8_BAR; PG8_MMA(0, 0, At, B0); PG8_MMA(0, 1, At, B1); PG8_BAR; PG8_SCHED;
            PG8_LDA(At, 1, 1); PG8_STAGE(PG8_SB(1, 0), b3, voffB); PG8_STAGE(PG8_SB(1, 1), b3 + hstep, voffB); PG8_STAGE(PG8_SA(1, 0), a3, voffA);
            PG8_WAIT_V(8); PG8_WAIT_L(0); PG8_BAR; PG8_MMA(1, 0, At, B0); PG8_MMA(1, 1, At, B1); PG8_BAR; PG8_SCHED;
        }
        if (wr == 0) PG8_BAR;
        if (E.kind == 0) epi_swiglu(a, E, acc, cur, wr, wc, fr, fq, rstab + ui * 256);
        else if (E.kind == 1) epi_resid(a, E, acc, cur, wr, wc, fr, fq);
        else epi_mix(a, E, acc, cur, wr, wc, fr, fq, rstab + ui * 256);
        if (!has_next) break;
#pragma unroll
        for (int a = 0; a < 2; ++a)
#pragma unroll
            for (int b = 0; b < 2; ++b)
#pragma unroll
                for (int m = 0; m < 4; ++m)
#pragma unroll
                    for (int n = 0; n < 2; ++n) acc[a][b][m][n] = (f32x4){0.f, 0.f, 0.f, 0.f};
        cur = nxt; cA = nA; cB = nB; ++ui;
        if (wr == 1) PG8_BAR;
    }
    PG8_WAIT_V(0);
    PG8_BAR;
#undef PG8_SA
#undef PG8_SB
#undef PG8_STAGE
#undef PG8_LDA
#undef PG8_LDB
#undef PG8_MMA
#undef PG8_WAIT_V
#undef PG8_WAIT_L
#undef PG8_BAR
#undef PG8_SCHED
}
}


__device__ __forceinline__ float wave_sum(float v) {
#pragma unroll
    for (int o = 1; o < 64; o <<= 1) v += __shfl_xor(v, o);
    return v;
}

__device__ __forceinline__ void p0_transpose_item(const float* W, int K, int Nsrc, int src_col0, const float* gs, bf16_t* WT, int dst_row0, LAS float* scr, int kb, int lane) {
    const int k0 = 64 * kb, r = lane >> 4, c4 = lane & 15;
    f32x4 v[16];
#pragma unroll
    for (int i = 0; i < 16; ++i) v[i] = *(const f32x4*)(W + (size_t)(k0 + 4 * i + r) * Nsrc + src_col0 + 4 * c4);
#pragma unroll
    for (int i = 0; i < 16; ++i) { const float g = gs ? gs[k0 + 4 * i + r] : 1.0f; LAS float* p = scr + (4 * i + r) * 65 + 4 * c4; p[0] = v[i].x * g; p[1] = v[i].y * g; p[2] = v[i].z * g; p[3] = v[i].w * g; }
    asm volatile("s_waitcnt lgkmcnt(0)" ::: "memory");
    const int c = lane & 7;
#pragma unroll
    for (int j = 0; j < 8; ++j) { const int n = (lane >> 3) + 8 * j; const LAS float* s = scr + (8 * c) * 65 + n;
        u32x4 o; o.x = cvt_pk_bf16(s[0 * 65], s[1 * 65]); o.y = cvt_pk_bf16(s[2 * 65], s[3 * 65]); o.z = cvt_pk_bf16(s[4 * 65], s[5 * 65]); o.w = cvt_pk_bf16(s[6 * 65], s[7 * 65]);
        *(u32x4*)(WT + (size_t)(dst_row0 + n) * K + k0 + 8 * c) = o; }
    asm volatile("s_waitcnt lgkmcnt(0)" ::: "memory");
}

__device__ __forceinline__ void p0_weights(const Args& a, LAS unsigned char* lds, int it_lo, int it_hi, int gw, int NGW, const int wid0) {
    unsigned char* const wsl = ws_reload();
    int tid = wid0 * 64 + (int)__builtin_amdgcn_mbcnt_hi(~0u, __builtin_amdgcn_mbcnt_lo(~0u, 0u)); asm volatile("" : "+v"(tid));
    const int lane = tid & 63, wave = tid >> 6;
    LAS float* scr = (LAS float*)(lds + wave * 16896);
    unsigned char* ws = wsl;
    constexpr int N13 = 2 * FF / 64, K13 = DM / 64, I13 = N13 * K13;
    constexpr int N2 = DM / 64, K2 = FF / 64, I2 = N2 * K2;
    constexpr int NIN = DIN / 64, KIN = DM / 64, IIN = NIN * KIN;
    constexpr int NO = DM / 64, KO = DM / 64, IO = NO * KO;
    constexpr int NITEMS = 2 * I13 + 2 * I2 + IIN + IO;
    static_assert(NITEMS == 5248 && I13 == 1408, "item map");
    for (int it = it_lo + gw; it < it_hi; it += NGW) {
        int r = it;
        if (r < 2 * I13) { const int which = r / I13; r -= which * I13; const int nb = r / K13, kb = r % K13, n0 = nb * 64, p = n0 >> 8, within = n0 & 255;
            const float* W = (within < 128) ? a.in[which ? I_F2W1 : I_F1W1] : a.in[which ? I_F2W3 : I_F1W3];
            p0_transpose_item(W, DM, FF, 128 * p + (within & 127), a.in[which ? I_N2 : I_N1], (bf16_t*)(ws + (which ? WS_W13B : WS_W13A)), n0, scr, kb, lane); continue; }
        r -= 2 * I13;
        if (r < 2 * I2) { const int which = r / I2; r -= which * I2; const int nb = r / K2, kb = r % K2;
            p0_transpose_item(a.in[which ? I_F2W2 : I_F1W2], FF, DM, nb * 64, nullptr, (bf16_t*)(ws + (which ? WS_W2B : WS_W2A)), nb * 64, scr, kb, lane); continue; }
        r -= 2 * I2;
        if (r < IIN) { const int nb = r / KIN, kb = r % KIN, n0 = nb * 64; int srcc;
            if (n0 < 1024) { const int p = n0 >> 8, within = n0 & 255; srcc = (within < 128) ? 128 * p + within : 512 + 128 * p + (within - 128); } else srcc = n0;
            p0_transpose_item(a.in[I_WIN], DM, DIN, srcc, a.in[I_NM], (bf16_t*)(ws + WS_WIN), n0, scr, kb, lane); continue; }
        r -= IIN;
        { const int nb = r / KO, kb = r % KO; p0_transpose_item(a.in[I_WOUT], DM, DM, nb * 64, nullptr, (bf16_t*)(ws + WS_WOUT), nb * 64, scr, kb, lane); }
    }
}
__device__ __forceinline__ void p0_rows(const Args& a, int G, const int wid0) {
    unsigned char* const wsl = ws_reload();
    int tid = wid0 * 64 + (int)__builtin_amdgcn_mbcnt_hi(~0u, __builtin_amdgcn_mbcnt_lo(~0u, 0u)); asm volatile("" : "+v"(tid));
    const int lane = tid & 63, wave = tid >> 6;
    const int gw = blockIdx.x * 8 + wave, NGW = G * 8;
    unsigned char* ws = wsl;
    float* ss = (float*)(ws + WS_SS); bf16_t* XA = (bf16_t*)(ws + WS_XA);
    for (int m0 = gw; m0 < MTOK; m0 += 4 * NGW) {
        f32x4 v[4][4];
#pragma unroll
        for (int q = 0; q < 4; ++q) { const int m = m0 + q * NGW; if (m < MTOK) { const float* xr = (m < MP) ? a.in[I_XP] + (size_t)m * DM : a.in[I_XS] + (size_t)(m - MP) * DM;
#pragma unroll
            for (int j = 0; j < 4; ++j) v[q][j] = ((const f32x4*)xr)[lane + 64 * j]; } }
#pragma unroll
        for (int q = 0; q < 4; ++q) { const int m = m0 + q * NGW; if (m < MTOK) {
            float s = 0.f;
#pragma unroll
            for (int j = 0; j < 4; ++j) s += (v[q][j].x * v[q][j].x + v[q][j].y * v[q][j].y) + (v[q][j].z * v[q][j].z + v[q][j].w * v[q][j].w);
            s = wave_sum(s);
            u32x2* o = (u32x2*)(XA + (size_t)m * DM);
#pragma unroll
            for (int j = 0; j < 4; ++j) { u32x2 w; w.x = cvt_pk_bf16(v[q][j].x, v[q][j].y); w.y = cvt_pk_bf16(v[q][j].z, v[q][j].w); o[lane + 64 * j] = w; }
            if (lane < 16) ss[(size_t)m * 16 + lane] = (lane == 0) ? s : 0.f; } }
    }
}

__device__ __forceinline__ void p8_final(const Args& a, int G, const int wid0) {
    unsigned char* const wsl = ws_reload();
    int tid = wid0 * 64 + (int)__builtin_amdgcn_mbcnt_hi(~0u, __builtin_amdgcn_mbcnt_lo(~0u, 0u)); asm volatile("" : "+v"(tid));
    const int lane = tid & 63, wave = tid >> 6;
    const int gw = blockIdx.x * 8 + wave, NGW = G * 8;
    const float* ss3 = (const float*)(wsl + WS_SS) + (size_t)3 * MTOK * 16;
    f32x4 g[4];
#pragma unroll
    for (int j = 0; j < 4; ++j) g[j] = ((const f32x4*)a.in[I_NF])[lane + 64 * j];
    for (int m = gw; m < MTOK; m += NGW) {
        f32x4* yr = (f32x4*)(a.out + OY + (size_t)m * DM);
        const u32x2* xr = (const u32x2*)((const bf16_t*)(wsl + WS_XA) + (size_t)m * DM);
        u32x2 xv[4];
#pragma unroll
        for (int j = 0; j < 4; ++j) xv[j] = xr[lane + 64 * j];
        const float rs = __builtin_amdgcn_rsqf(ss_row(ss3, (size_t)m, lane & 3, 1) * (1.0f / DM) + EPS);
#pragma unroll
        for (int j = 0; j < 4; ++j) { const f32x4 v = (f32x4){bflo(xv[j].x), bfhi(xv[j].x), bflo(xv[j].y), bfhi(xv[j].y)}; yr[lane + 64 * j] = v * rs * g[j]; }
    }
}

constexpr int CV_TT = 32, CV_WIN = CV_TT + 30, CV_YOFF = CV_WIN * DC * 2, CV_YLD = DC + 4, CV_NITEMS = NB * (TP / CV_TT) + NB * (TS / CV_TT);
static_assert(CV_YOFF + CV_TT * CV_YLD * 4 <= LDS_BYTES, "conv LDS");
typedef float f32x2c __attribute__((ext_vector_type(2)));
__device__ __forceinline__ void conv_decode(int item, int& seq, int& t0, int& rowbase, bool& sample) {
    if (item < NB * (TP / CV_TT)) { seq = item / (TP / CV_TT); t0 = (item % (TP / CV_TT)) * CV_TT; rowbase = seq * TP; sample = false; }
    else { const int j = item - NB * (TP / CV_TT); seq = j / (TS / CV_TT); t0 = (j % (TS / CV_TT)) * CV_TT; rowbase = MP + seq * TS; sample = true; }
}
__device__ __forceinline__ void conv_load(u32x4 (&W)[8], const Args& a, int item, int tid) {
    unsigned char* const wsl = ws_reload();
    int seq, t0, rowbase; bool sample; conv_decode(item, seq, t0, rowbase, sample);
    const bf16_t* U = (const bf16_t*)(wsl + WS_U);
#pragma unroll
    for (int p = 0; p < 8; ++p) {
        const int idx = tid + 512 * p, i = idx >> 6, ch = (idx & 63) * 8, t = t0 - 30 + i;
        u32x4 v = (u32x4){0u, 0u, 0u, 0u};
        if (idx < CV_WIN * (DC / 8)) {
            if (t >= 0) v = *(const u32x4*)(U + (size_t)(rowbase + t) * DC + ch);
            else if (sample) { const float* s = a.in[I_SCONV] + ((size_t)(seq * 30 + 30 + t) * DC + ch); const f32x4 s0 = *(const f32x4*)s, s1 = *(const f32x4*)(s + 4);
                v.x = cvt_pk_bf16(s0.x, s0.y); v.y = cvt_pk_bf16(s0.z, s0.w); v.z = cvt_pk_bf16(s1.x, s1.y); v.w = cvt_pk_bf16(s1.z, s1.w); }
        }
        W[p] = v;
    }
}
__device__ __forceinline__ void conv_items(const Args& a, LAS unsigned char* lds, int first, int stride, const int wid0) {
    unsigned char* const wsl = ws_reload();
    int tid = wid0 * 64 + (int)__builtin_amdgcn_mbcnt_hi(~0u, __builtin_amdgcn_mbcnt_lo(~0u, 0u)); asm volatile("" : "+v"(tid));
    const int lane = tid & 63, wave = tid >> 6;
    if (first >= CV_NITEMS) return;
    bf16_t* CR = (bf16_t*)(wsl + WS_CR);
    const int cp = tid & 255, th = tid >> 8;
    f32x2c w2[CW];
#pragma unroll
    for (int j = 0; j < CW; ++j) w2[j] = *(const f32x2c*)(a.in[I_DWW] + j * DC + 2 * cp);
    const f32x2c bias2 = *(const f32x2c*)(a.in[I_DWB] + 2 * cp);
    const f32x4 g0 = *(const f32x4*)(a.in[I_LNG] + lane * 8), g1 = *(const f32x4*)(a.in[I_LNG] + lane * 8 + 4);
    const f32x4 b0 = *(const f32x4*)(a.in[I_LNB] + lane * 8), b1 = *(const f32x4*)(a.in[I_LNB] + lane * 8 + 4);
    u32x4 W[8];
    conv_load(W, a, first, tid);
    for (int item = first; item < CV_NITEMS; item += stride) {
        int seq, t0, rowbase; bool sample; conv_decode(item, seq, t0, rowbase, sample);
#pragma unroll
        for (int p = 0; p < 8; ++p) { const int idx = tid + 512 * p; if (idx < CV_WIN * (DC / 8)) *(LAS u32x4*)(lds + (size_t)idx * 16) = W[p]; }
        LBAR();
        if (item + stride < CV_NITEMS) conv_load(W, a, item + stride, tid);
        f32x2c acc[16];
#pragma unroll
        for (int t = 0; t < 16; ++t) acc[t] = bias2;
#pragma unroll
        for (int i = 0; i < 46; ++i) {
            const unsigned xw = *(const LAS unsigned*)(lds + ((th * 16 + i) * DC + 2 * cp) * 2);
            const f32x2c x2 = (f32x2c){bflo(xw), bfhi(xw)};
#pragma unroll
            for (int t = 0; t < 16; ++t) if (i - t >= 0 && i - t < CW) acc[t] = acc[t] + x2 * w2[i - t];
        }
        LAS float* yb = (LAS float*)(lds + CV_YOFF);
#pragma unroll
        for (int t = 0; t < 16; ++t) *(LAS f32x2c*)(yb + (th * 16 + t) * CV_YLD + 2 * cp) = acc[t];
        LBAR();
#pragma unroll
        for (int q = 0; q < 4; ++q) {
            const int tt = wave * 4 + q;
            const f32x4 y0 = *(const LAS f32x4*)(yb + tt * CV_YLD + lane * 8), y1 = *(const LAS f32x4*)(yb + tt * CV_YLD + lane * 8 + 4);
            const float mu = wave_sum((y0.x + y0.y) + (y0.z + y0.w) + (y1.x + y1.y) + (y1.z + y1.w)) * (1.0f / DC);
            const f32x4 d0 = y0 - mu, d1 = y1 - mu;
            const float var = wave_sum((d0.x * d0.x + d0.y * d0.y) + (d0.z * d0.z + d0.w * d0.w) + (d1.x * d1.x + d1.y * d1.y) + (d1.z * d1.z + d1.w * d1.w)) * (1.0f / DC);
            const float rs = __builtin_amdgcn_rsqf(var + EPS);
            const f32x4 z0 = d0 * rs * g0 + b0, z1 = d1 * rs * g1 + b1;
            u32x4 o; o.x = cvt_pk_bf16(siluf_(z0.x), siluf_(z0.y)); o.y = cvt_pk_bf16(siluf_(z0.z), siluf_(z0.w)); o.z = cvt_pk_bf16(siluf_(z1.x), siluf_(z1.y)); o.w = cvt_pk_bf16(siluf_(z1.z), siluf_(z1.w));
            *(u32x4*)(CR + (size_t)(rowbase + t0 + tt) * DM + lane * 8) = o;
        }
        LBAR();
    }
}

constexpr int SC_QS = 0, SC_QE = 17408, SC_KE = 34816, SC_KET = 52224, SC_VT = 70656, SC_P = 89088, SC_SEG = 98304, SC_DEC = 102400, SC_OB = 103424, SC_ENDB = SC_OB + 64 * 132 * 4;
constexpr int SC_LD = 272, SC_LDT = 144, SC_OLD = 132;
static_assert(SC_ENDB <= LDS_BYTES - 64, "scan LDS");
typedef float f32x2 __attribute__((ext_vector_type(2)));
struct ScanRaw { f32x2 lf[8]; unsigned q[8], k[8], v[8]; };
__device__ __forceinline__ void scan_load(ScanRaw& r, const float* LF, const bf16_t* Qb, const bf16_t* Kb, const bf16_t* Vb, size_t row0, int col) {
#pragma unroll
    for (int i = 0; i < 8; ++i) { const size_t o = (row0 + i) * DH + col; r.lf[i] = *(const f32x2*)(LF + o); r.q[i] = *(const unsigned*)(Qb + o); r.k[i] = *(const unsigned*)(Kb + o); r.v[i] = *(const unsigned*)(Vb + o); }
}
__device__ __forceinline__ void scan_item(const Args& a, LAS unsigned char* lds, bool sample, int seq, int h, const int wid0) {
    unsigned char* const wsl = ws_reload();
    int tid = wid0 * 64 + (int)__builtin_amdgcn_mbcnt_hi(~0u, __builtin_amdgcn_mbcnt_lo(~0u, 0u)); asm volatile("" : "+v"(tid));
    const int lane = tid & 63, w = __builtin_amdgcn_readfirstlane(tid >> 6), l15 = lane & 15, quad = lane >> 4;
    const int T = sample ? TS : TP, rowbase = sample ? MP + seq * TS : seq * TP, nchunk = T / 64;
    const bf16_t* Qb = (const bf16_t*)(wsl + WS_Q); const bf16_t* Kb = (const bf16_t*)(wsl + WS_K); const bf16_t* Vb = (const bf16_t*)(wsl + WS_V); const bf16_t* Gb = (const bf16_t*)(wsl + WS_G);
    const float* LF = (const float*)(wsl + WS_LF); bf16_t* CR = (bf16_t*)(wsl + WS_CR);
    const int kp = lane, seg = w, col = h * 128 + 2 * kp;
    f32x4 sacc[8];
    if (sample) { const float* s0 = a.in[I_SHGRN] + (size_t)(seq * 4 + h) * 128 * 128;
#pragma unroll
        for (int kb = 0; kb < 8; ++kb)
#pragma unroll
            for (int j = 0; j < 4; ++j) sacc[kb][j] = s0[(size_t)(16 * kb + 4 * quad + j) * 128 + 16 * w + l15];
    } else {
#pragma unroll
        for (int kb = 0; kb < 8; ++kb) sacc[kb] = (f32x4){0.f, 0.f, 0.f, 0.f};
    }
    LAS f32x2* segs = (LAS f32x2*)(lds + SC_SEG); LAS float* dec = (LAS float*)(lds + SC_DEC); LAS float* ob = (LAS float*)(lds + SC_OB);
    const int ot = tid >> 3, ov0 = (tid & 7) * 16;
    bool pend = false; size_t p_orow = 0; u32x4 p_g0 = (u32x4){0u, 0u, 0u, 0u}, p_g1 = p_g0;
    ScanRaw R;
    scan_load(R, LF, Qb, Kb, Vb, (size_t)rowbase + seg * 8, col);
    for (int c = 0; c < nchunk; ++c) {
        f32x2 cs[8]; f32x2 run = (f32x2){0.f, 0.f};
#pragma unroll
        for (int i = 0; i < 8; ++i) { run = run + R.lf[i]; cs[i] = run; }
        segs[seg * 64 + kp] = run;
        LBAR();
        if (pend) {
            const size_t orow = p_orow; const u32x4 gq0 = p_g0, gq1 = p_g1;
            {
                f32x4 o[4]; float sq = 0.f;
#pragma unroll
                for (int i = 0; i < 4; ++i) { o[i] = *(const LAS f32x4*)(ob + ot * SC_OLD + ov0 + 4 * i); sq += (o[i].x * o[i].x + o[i].y * o[i].y) + (o[i].z * o[i].z + o[i].w * o[i].w); }
                sq += __shfl_xor(sq, 1); sq += __shfl_xor(sq, 2); sq += __shfl_xor(sq, 4);
                const float rs = __builtin_amdgcn_rsqf(sq * (1.0f / 128.0f) + EPS);
                u32x4 r0v, r1v;
                r0v.x = cvt_pk_bf16(o[0].x * rs * bflo(gq0.x), o[0].y * rs * bfhi(gq0.x)); r0v.y = cvt_pk_bf16(o[0].z * rs * bflo(gq0.y), o[0].w * rs * bfhi(gq0.y));
                r0v.z = cvt_pk_bf16(o[1].x * rs * bflo(gq0.z), o[1].y * rs * bfhi(gq0.z)); r0v.w = cvt_pk_bf16(o[1].z * rs * bflo(gq0.w), o[1].w * rs * bfhi(gq0.w));
                r1v.x = cvt_pk_bf16(o[2].x * rs * bflo(gq1.x), o[2].y * rs * bfhi(gq1.x)); r1v.y = cvt_pk_bf16(o[2].z * rs * bflo(gq1.y), o[2].w * rs * bfhi(gq1.y));
                r1v.z = cvt_pk_bf16(o[3].x * rs * bflo(gq1.z), o[3].y * rs * bfhi(gq1.z)); r1v.w = cvt_pk_bf16(o[3].z * rs * bflo(gq1.w), o[3].w * rs * bfhi(gq1.w));
                bf16_t* dst = CR + orow * DM + DC + h * 128 + ov0;
                *(u32x4*)dst = r0v; *(u32x4*)(dst + 8) = r1v;
            }
        }
        f32x2 off = (f32x2){0.f, 0.f}, tot = (f32x2){0.f, 0.f};
#pragma unroll
        for (int s = 0; s < 8; ++s) { const f32x2 v = segs[s * 64 + kp]; if (s < seg) off = off + v; tot = tot + v; }
        const f32x2 etot = (f32x2){__expf(tot.x), __expf(tot.y)};
        if (seg == 0) *(LAS f32x2*)(dec + 2 * kp) = etot;
        unsigned ke0[4], ke1[4], v0[4], v1[4];
#pragma unroll
        for (int i = 0; i < 8; ++i) {
            const f32x2 b = off + cs[i];
            const float q0 = bflo(R.q[i]), q1 = bfhi(R.q[i]), k0 = bflo(R.k[i]), k1 = bfhi(R.k[i]);
            const float e0 = __expf(b.x), e1 = __expf(b.y);
            const float qs0 = q0 * e0, qs1 = q1 * e1;
            const unsigned pq = cvt_pk_bf16(qs0, qs1);
            const unsigned pk = cvt_pk_bf16(k0 * __builtin_amdgcn_rcpf(e0), k1 * __builtin_amdgcn_rcpf(e1));
            const int t = seg * 8 + i;
            *(LAS unsigned*)(lds + SC_QS + t * SC_LD + kp * 4) = pq;
            *(LAS unsigned*)(lds + SC_KE + t * SC_LD + kp * 4) = pk;
            if (i & 1) { ke0[i >> 1] |= pk << 16; ke1[i >> 1] |= pk & 0xffff0000u; v0[i >> 1] |= R.v[i] << 16; v1[i >> 1] |= R.v[i] & 0xffff0000u; }
            else { ke0[i >> 1] = pk & 0xffffu; ke1[i >> 1] = pk >> 16; v0[i >> 1] = R.v[i] & 0xffffu; v1[i >> 1] = R.v[i] >> 16; }
        }
        *(LAS u32x4*)(lds + SC_KET + (2 * kp) * SC_LDT + seg * 16) = (u32x4){ke0[0], ke0[1], ke0[2], ke0[3]};
        *(LAS u32x4*)(lds + SC_KET + (2 * kp + 1) * SC_LDT + seg * 16) = (u32x4){ke1[0], ke1[1], ke1[2], ke1[3]};
        *(LAS u32x4*)(lds + SC_VT + (2 * kp) * SC_LDT + seg * 16) = (u32x4){v0[0], v0[1], v0[2], v0[3]};
        *(LAS u32x4*)(lds + SC_VT + (2 * kp + 1) * SC_LDT + seg * 16) = (u32x4){v1[0], v1[1], v1[2], v1[3]};
        LBAR();
        if (c + 1 < nchunk) scan_load(R, LF, Qb, Kb, Vb, (size_t)rowbase + (c + 1) * 64 + seg * 8, col);
        {
            const int tb = w & 3;
#pragma unroll
            for (int sbi = 0; sbi < 2; ++sbi) {
                const int sb = (w >> 2) * 2 + sbi;
                f32x4 pacc = (f32x4){0.f, 0.f, 0.f, 0.f};
                if (sb <= tb) {
#pragma unroll
                    for (int kt = 0; kt < 4; ++kt) {
                        const bf16x8 af = *(const LAS bf16x8*)(lds + SC_KE + (16 * sb + l15) * SC_LD + (32 * kt + 8 * quad) * 2);
                        const bf16x8 bf = *(const LAS bf16x8*)(lds + SC_QS + (16 * tb + l15) * SC_LD + (32 * kt + 8 * quad) * 2);
                        pacc = __builtin_amdgcn_mfma_f32_16x16x32_bf16(af, bf, pacc, 0, 0, 0);
                    }
                    const int t = 16 * tb + l15, s = 16 * sb + 4 * quad;
#pragma unroll
                    for (int j = 0; j < 4; ++j) if (s + j > t) pacc[j] = 0.f;
                }
                u32x2 p; p.x = cvt_pk_bf16(pacc[0], pacc[1]); p.y = cvt_pk_bf16(pacc[2], pacc[3]);
                *(LAS u32x2*)(lds + SC_P + (16 * tb + l15) * SC_LDT + (16 * sb + 4 * quad) * 2) = p;
            }
        }
        f32x4 oacc[4];
#pragma unroll
        for (int tb = 0; tb < 4; ++tb) oacc[tb] = (f32x4){0.f, 0.f, 0.f, 0.f};
#pragma unroll
        for (int kt = 0; kt < 4; ++kt) {
            u32x4 ap; ap.x = cvt_pk_bf16(sacc[2 * kt][0], sacc[2 * kt][1]); ap.y = cvt_pk_bf16(sacc[2 * kt][2], sacc[2 * kt][3]);
            ap.z = cvt_pk_bf16(sacc[2 * kt + 1][0], sacc[2 * kt + 1][1]); ap.w = cvt_pk_bf16(sacc[2 * kt + 1][2], sacc[2 * kt + 1][3]);
            const bf16x8 af = __builtin_bit_cast(bf16x8, ap);
#pragma unroll
            for (int tb = 0; tb < 4; ++tb) {
                const u32x2 lo = *(const LAS u32x2*)(lds + SC_QS + (16 * tb + l15) * SC_LD + (32 * kt + 4 * quad) * 2);
                const u32x2 hi = *(const LAS u32x2*)(lds + SC_QS + (16 * tb + l15) * SC_LD + (32 * kt + 16 + 4 * quad) * 2);
                const bf16x8 bf = __builtin_bit_cast(bf16x8, (u32x4){lo.x, lo.y, hi.x, hi.y});
                oacc[tb] = __builtin_amdgcn_mfma_f32_16x16x32_bf16(af, bf, oacc[tb], 0, 0, 0);
            }
        }
        const size_t orow = (size_t)rowbase + c * 64 + ot;
        const u32x4 gq0 = *(const u32x4*)(Gb + orow * DH + h * 128 + ov0), gq1 = *(const u32x4*)(Gb + orow * DH + h * 128 + ov0 + 8);
        LBAR();
        bf16x8 vf[2];
#pragma unroll
        for (int st = 0; st < 2; ++st) vf[st] = *(const LAS bf16x8*)(lds + SC_VT + (16 * w + l15) * SC_LDT + (32 * st + 8 * quad) * 2);
#pragma unroll
        for (int tb = 0; tb < 4; ++tb)
#pragma unroll
            for (int st = 0; st < 2; ++st) {
                const bf16x8 bf = *(const LAS bf16x8*)(lds + SC_P + (16 * tb + l15) * SC_LDT + (32 * st + 8 * quad) * 2);
                oacc[tb] = __builtin_amdgcn_mfma_f32_16x16x32_bf16(vf[st], bf, oacc[tb], 0, 0, 0);
            }
#pragma unroll
        for (int tb = 0; tb < 4; ++tb) *(LAS f32x4*)(ob + (16 * tb + l15) * SC_OLD + 16 * w + 4 * quad) = oacc[tb];
#pragma unroll
        for (int kb = 0; kb < 8; ++kb) {
            const f32x4 d = *(const LAS f32x4*)(dec + 16 * kb + 4 * quad);
#pragma unroll
            for (int st = 0; st < 2; ++st) {
                const bf16x8 af = *(const LAS bf16x8*)(lds + SC_KET + (16 * kb + l15) * SC_LDT + (32 * st + 8 * quad) * 2);
                sacc[kb] = __builtin_amdgcn_mfma_f32_16x16x32_bf16(af, vf[st], sacc[kb], 0, 0, 0);
            }
            sacc[kb] = sacc[kb] * d;
        }
        pend = true; p_orow = orow; p_g0 = gq0; p_g1 = gq1;
    }
    LBAR();
    {
        const size_t orow = p_orow; const u32x4 gq0 = p_g0, gq1 = p_g1;
    {
        f32x4 o[4]; float sq = 0.f;
#pragma unroll
        for (int i = 0; i < 4; ++i) { o[i] = *(const LAS f32x4*)(ob + ot * SC_OLD + ov0 + 4 * i); sq += (o[i].x * o[i].x + o[i].y * o[i].y) + (o[i].z * o[i].z + o[i].w * o[i].w); }
        sq += __shfl_xor(sq, 1); sq += __shfl_xor(sq, 2); sq += __shfl_xor(sq, 4);
        const float rs = __builtin_amdgcn_rsqf(sq * (1.0f / 128.0f) + EPS);
        u32x4 r0v, r1v;
        r0v.x = cvt_pk_bf16(o[0].x * rs * bflo(gq0.x), o[0].y * rs * bfhi(gq0.x)); r0v.y = cvt_pk_bf16(o[0].z * rs * bflo(gq0.y), o[0].w * rs * bfhi(gq0.y));
        r0v.z = cvt_pk_bf16(o[1].x * rs * bflo(gq0.z), o[1].y * rs * bfhi(gq0.z)); r0v.w = cvt_pk_bf16(o[1].z * rs * bflo(gq0.w), o[1].w * rs * bfhi(gq0.w));
        r1v.x = cvt_pk_bf16(o[2].x * rs * bflo(gq1.x), o[2].y * rs * bfhi(gq1.x)); r1v.y = cvt_pk_bf16(o[2].z * rs * bflo(gq1.y), o[2].w * rs * bfhi(gq1.y));
        r1v.z = cvt_pk_bf16(o[3].x * rs * bflo(gq1.z), o[3].y * rs * bfhi(gq1.z)); r1v.w = cvt_pk_bf16(o[3].z * rs * bflo(gq1.w), o[3].w * rs * bfhi(gq1.w));
        bf16_t* dst = CR + orow * DM + DC + h * 128 + ov0;
        *(u32x4*)dst = r0v; *(u32x4*)(dst + 8) = r1v;
    }
    }
    float* so = a.out + (sample ? OHS : OHP) + (size_t)(seq * 4 + h) * 128 * 128;
#pragma unroll
    for (int kb = 0; kb < 8; ++kb)
#pragma unroll
        for (int j = 0; j < 4; ++j) so[(size_t)(16 * kb + 4 * quad + j) * 128 + 16 * w + l15] = sacc[kb][j];
    LBAR();
}

__device__ __forceinline__ void small_resid_gemm(const Args& a, LAS unsigned char* lds, int ph, const int wid0) {
    unsigned char* const wsl = ws_reload();
    int tid = wid0 * 64 + (int)__builtin_amdgcn_mbcnt_hi(~0u, __builtin_amdgcn_mbcnt_lo(~0u, 0u)); asm volatile("" : "+v"(tid));
    const int lane = tid & 63, w = __builtin_amdgcn_readfirstlane(tid >> 6), l15 = lane & 15, quad = lane >> 4;
    const int b = blockIdx.x; if (b >= 256) return;
    const int rb = b >> 4, cb = b & 15;
    const int K = (ph == 5) ? DM : FF, nblk = K / 64;
    const bf16_t* A = (const bf16_t*)(wsl + (ph == 5 ? WS_CR : WS_H)) + (size_t)(MP + 64 * rb + l15) * K + 16 * quad;
    const bf16_t* B = (const bf16_t*)(wsl + (ph == 2 ? WS_W2A : ph == 5 ? WS_WOUT : WS_W2B)) + (size_t)(64 * cb + l15) * K + 16 * quad;
    f32x4 acc[4][4];
#pragma unroll
    for (int rt = 0; rt < 4; ++rt)
#pragma unroll
        for (int ct = 0; ct < 4; ++ct) acc[rt][ct] = (f32x4){0.f, 0.f, 0.f, 0.f};
    for (int blk0 = w; blk0 < nblk; blk0 += 16) {
        bf16x8 af[2][2][4], bf[2][2][4];
#pragma unroll
        for (int q = 0; q < 2; ++q) { const int blk = blk0 + 8 * q; if (blk < nblk) {
#pragma unroll
            for (int h = 0; h < 2; ++h)
#pragma unroll
                for (int t = 0; t < 4; ++t) { af[q][h][t] = *(const bf16x8*)(A + (size_t)(16 * t) * K + blk * 64 + 8 * h); bf[q][h][t] = *(const bf16x8*)(B + (size_t)(16 * t) * K + blk * 64 + 8 * h); } } }
#pragma unroll
        for (int q = 0; q < 2; ++q) { const int blk = blk0 + 8 * q; if (blk < nblk) {
#pragma unroll
            for (int h = 0; h < 2; ++h)
#pragma unroll
                for (int rt = 0; rt < 4; ++rt)
#pragma unroll
                    for (int ct = 0; ct < 4; ++ct) acc[rt][ct] = __builtin_amdgcn_mfma_f32_16x16x32_bf16(bf[q][h][ct], af[q][h][rt], acc[rt][ct], 0, 0, 0); } }
    }
    constexpr int PP = 68;
    LAS float* part = (LAS float*)(lds + (size_t)w * (64 * PP * 4));
#pragma unroll
    for (int rt = 0; rt < 4; ++rt)
#pragma unroll
        for (int ct = 0; ct < 4; ++ct) *(LAS f32x4*)(part + (16 * rt + l15) * PP + 16 * ct + 4 * quad) = acc[rt][ct];
    LBAR();
    const int r = tid >> 3, c8 = (tid & 7) * 8;
    f32x4 o0 = (f32x4){0.f, 0.f, 0.f, 0.f}, o1 = o0;
#pragma unroll
    for (int ww = 0; ww < 8; ++ww) { const LAS float* p = (const LAS float*)(lds + (size_t)ww * (64 * PP * 4)) + r * PP + c8; o0 = o0 + *(const LAS f32x4*)p; o1 = o1 + *(const LAS f32x4*)(p + 4); }
    const size_t grow = (size_t)MP + 64 * rb + r;
    const int col = 64 * cb + c8;
    bf16_t* xa = (bf16_t*)(wsl + WS_XA);
    const float scale = (ph == 5) ? 1.0f : 0.5f;
    f32x4 b0, b1;
    if (ph == 2 && !MK_XABASE) { const float* xs = a.in[I_XS] + (grow - MP) * DM + col; b0 = *(const f32x4*)xs; b1 = *(const f32x4*)(xs + 4); }
    else { const u32x4 rr = *(const u32x4*)(xa + grow * DM + col); b0 = (f32x4){bflo(rr.x), bfhi(rr.x), bflo(rr.y), bfhi(rr.y)}; b1 = (f32x4){bflo(rr.z), bfhi(rr.z), bflo(rr.w), bfhi(rr.w)}; }
    o0 = b0 + o0 * scale; o1 = b1 + o1 * scale;
    u32x4 wv; wv.x = cvt_pk_bf16(o0[0], o0[1]); wv.y = cvt_pk_bf16(o0[2], o0[3]); wv.z = cvt_pk_bf16(o1[0], o1[1]); wv.w = cvt_pk_bf16(o1[2], o1[3]);
    *(u32x4*)(xa + grow * DM + col) = wv;
    float s = ((o0[0] * o0[0] + o0[1] * o0[1]) + (o0[2] * o0[2] + o0[3] * o0[3])) + ((o1[0] * o1[0] + o1[1] * o1[1]) + (o1[2] * o1[2] + o1[3] * o1[3]));
    s += __shfl_xor(s, 1); s += __shfl_xor(s, 2); s += __shfl_xor(s, 4);
    if ((tid & 7) == 0) { float* ss_out = (float*)(wsl + WS_SS) + (size_t)(ph == 2 ? 1 : (ph == 5 ? 2 : 3)) * MTOK * 16; ss_out[grow * 16 + cb] = s; }
    LBAR();
}

#define XB_TMO      128
#define XB_XCNT(j)  (256  + 64 * (j))
#define XB_XSUB(j)  (1280 + 64 * (j))
#define XB_XGEN(j)  (2304 + 64 * (j))
#define XB_TOP      3328
#define XB_TOPGEN   3392
#define XCD_BAR_WORDS 3456
#define XB_SPIN_CAP (1u << 18)

__device__ __forceinline__ unsigned xb_ld(unsigned* p)              { return __hip_atomic_load(p, __ATOMIC_RELAXED, __HIP_MEMORY_SCOPE_AGENT); }
__device__ __forceinline__ unsigned xb_add(unsigned* p, unsigned v) { return __hip_atomic_fetch_add(p, v, __ATOMIC_RELAXED, __HIP_MEMORY_SCOPE_AGENT); }
__device__ __forceinline__ unsigned xb_xcc_id() { return (unsigned)__builtin_amdgcn_s_getreg((3 << 11) | 20) & 0xFu; }
#define XB_SPIN(cond, bar) do { unsigned _sp = 0; while (cond) { __builtin_amdgcn_s_sleep(1); \
    if ((++_sp & 255u) == 0u) { if (xb_ld(&(bar)[XB_TMO])) break; if (_sp > XB_SPIN_CAP) { atomicAdd(&(bar)[XB_TMO], 1u); break; } } } } while (0)

struct XcdBarrier {
    unsigned total;
    unsigned* bar; unsigned x;
    volatile LAS unsigned* st;
};

__device__ __forceinline__ XcdBarrier xcd_barrier_post(unsigned* bar, volatile LAS unsigned* st, bool t0, unsigned total) {
    XcdBarrier b; b.total = total; b.bar = bar; b.x = xb_xcc_id(); b.st = st;
    if (t0) (void)xb_add(&bar[XB_XCNT(b.x)], 1u);
    return b;
}
__device__ __forceinline__ void xcd_barrier_complete(unsigned* bar, unsigned x, unsigned& nloc, unsigned& nx, const unsigned G) {
    unsigned sum, cnt, mine, sp = 0u;
    for (;;) {
        sum = 0u; cnt = 0u; mine = 0u;
#pragma unroll
        for (unsigned j = 0; j < 16; ++j) { const unsigned c = xb_ld(&bar[XB_XCNT(j)]); sum += c; cnt += (c > 0u) ? 1u : 0u; mine = (j == x) ? c : mine; }
        if (sum == G) break;
        __builtin_amdgcn_s_sleep(1);
        if ((++sp & 255u) == 0u) { if (xb_ld(&bar[XB_TMO])) break; if (sp > XB_SPIN_CAP) { atomicAdd(&bar[XB_TMO], 1u); break; } }
    }
    nloc = mine > 0u ? mine : 1u; nx = cnt > 0u ? cnt : 1u;
}

__device__ __forceinline__ void xcd_barrier(const XcdBarrier& b, const int wid0) {
    const bool t0 = (wid0 == 0) && (__builtin_amdgcn_mbcnt_hi(~0u, __builtin_amdgcn_mbcnt_lo(~0u, 0u)) == 0u);
    asm volatile("s_waitcnt vmcnt(0)" ::: "memory");
    __syncthreads();
    if (t0) {
        unsigned* bar = b.bar;
        __builtin_amdgcn_s_waitcnt(0);
        unsigned nloc = b.st[0], nx = b.st[1];
        if (nloc == 0u) { xcd_barrier_complete(bar, b.x, nloc, nx, b.total); b.st[0] = nloc; b.st[1] = nx; }
        const unsigned old = xb_add(&bar[XB_XSUB(b.x)], 1u);
        const unsigned gen = old / nloc;
        if (old + 1u == (gen + 1u) * nloc) {
            __builtin_amdgcn_fence(__ATOMIC_RELEASE, "agent");
            asm volatile("s_waitcnt vmcnt(0)" ::: "memory");
            const unsigned og = xb_add(&bar[XB_TOP], 1u);
            const unsigned tg = og / nx;
            if (og + 1u == (tg + 1u) * nx) xb_add(&bar[XB_TOPGEN], 1u);
            else XB_SPIN(xb_ld(&bar[XB_TOPGEN]) == tg, bar);
            __builtin_amdgcn_fence(__ATOMIC_ACQUIRE, "agent");
            xb_add(&bar[XB_XGEN(b.x)], 1u);
            asm volatile("s_waitcnt vmcnt(0)" ::: "memory");
        } else {
            XB_SPIN(xb_ld(&bar[XB_XGEN(b.x)]) == gen, bar);
            __builtin_amdgcn_fence(__ATOMIC_ACQUIRE, "agent");
            asm volatile("s_waitcnt vmcnt(0)" ::: "memory");
        }
    }
    __syncthreads();
}


__global__ void __launch_bounds__(512, 2) fwd_megakernel(Args a) {
    extern __shared__ __attribute__((aligned(16))) unsigned char lds_raw[];
    LAS unsigned char* lds = (LAS unsigned char*)lds_raw;
    cg::grid_group grid = cg::this_grid();
    const int G = gridDim.x;
    const int wid0 = __builtin_amdgcn_readfirstlane((int)threadIdx.x >> 6);
    volatile LAS unsigned* bst = (volatile LAS unsigned*)(lds + LDS_BYTES - 64);
    if (threadIdx.x < 4) bst[threadIdx.x] = 0u;
    const bool thr0 = threadIdx.x == 0;
    __syncthreads();
    grid.sync();
    XcdBarrier xbar = xcd_barrier_post((unsigned*)(a.ws + WS_BAR), bst, thr0, (unsigned)G);
    XcdBarrier xbar2 = xbar;
    if (blockIdx.x >= 64) xbar2 = xcd_barrier_post((unsigned*)(a.ws + WS_BAR + 16384), bst + 2, thr0, (unsigned)(G - 64));
    for (int pi = a.ph_lo; pi < a.ph_hi; ++pi) {
        unsigned char* ws = ws_reload();
        const int ph = (MK_DUP >= 0 && pi > MK_DUP) ? pi - 1 : pi;
        if (ph == 0) { p0_weights(a, lds, 0, 1408, (int)blockIdx.x * 8 + wid0, G * 8, wid0); p0_rows(a, G, wid0); }
        else if (ph == 4) {
            const int b = blockIdx.x;
            if (b < 64) scan_item(a, lds, false, b >> 2, b & 3, wid0);
            else {
                pg8::Gemm g{(const bf16_t*)(ws + WS_XA), (const bf16_t*)(ws + WS_WIN), MTOK, DM, DM};
                pg8::Epi E{2, 1, 3, 0, 0};
                pg8::StaticOrder S; S.init(g.M, g.N, G - 64, b - 64);
                pg8::gemm_phase(a, lds, g, S, E, wid0);
                pg8::Gemm g2{(const bf16_t*)(ws + WS_XA) + (size_t)MP * DM, (const bf16_t*)(ws + WS_WIN) + (size_t)4 * 256 * DM, MS, DIN - 4 * 256, DM};
                pg8::Epi E2{2, 1, 3, 4, MP / 256};
                pg8::StaticOrder S2; S2.init(g2.M, g2.N, G - 64, b - 64);
                pg8::gemm_phase(a, lds, g2, S2, E2, wid0);
                xcd_barrier(xbar2, wid0);
                if (b < 128) scan_item(a, lds, true, (b - 64) >> 2, b & 3, wid0);
                conv_items(a, lds, b - 64, G - 64, wid0);
            }
        }
        else if (ph == 8) p8_final(a, G, wid0);
        else {
            const bool up = (ph == 1 || ph == 6), down = (ph == 2 || ph == 7);
            const size_t aoff = down ? WS_H : (ph == 5 ? WS_CR : WS_XA);
            const size_t boff = ph == 1 ? WS_W13A : ph == 2 ? WS_W2A : ph == 3 ? WS_WIN : ph == 5 ? WS_WOUT : ph == 6 ? WS_W13B : WS_W2B;
            const bool resid = down || ph == 5;
            pg8::Gemm g{(const bf16_t*)(ws + aoff), (const bf16_t*)(ws + boff + (ph == 3 ? (size_t)4 * 256 * DM * 2 : 0)), (resid || ph == 3) ? MP : MTOK, up ? 2 * FF : (ph == 3 ? DIN - 4 * 256 : DM), down ? FF : DM};
            pg8::Epi E{up ? 0 : (ph == 3 ? 2 : 1), 1, ph, ph == 3 ? 4 : 0, 0};
            pg8::StaticOrder S; S.init(g.M, g.N, G, (int)blockIdx.x);
            pg8::gemm_phase(a, lds, g, S, E, wid0);
            if (ph == 1 && G == 256 && (int)blockIdx.x >= 88) p0_weights(a, lds, 1408, 5248, ((int)blockIdx.x - 88) * 8 + wid0, 168 * 8, wid0);
            if (ph == 1 && G != 256 && blockIdx.x == 0) p0_weights(a, lds, 1408, 5248, wid0, 8, wid0);
            if (resid) small_resid_gemm(a, lds, ph, wid0);
        }
        if (pi + 1 < a.ph_hi) xcd_barrier(xbar, wid0);
    }
}

extern "C" void kernel_launch(void* const* d_in, const int* in_sizes, int n_in, void* d_out, int out_size, void* d_ws, size_t ws_size, hipStream_t stream) {
    static int grid = 0;
    if (grid == 0) {
        if (n_in != 22 || ws_size < WS_END) { fprintf(stderr, "kernel_launch: unexpected n_in %d / ws %zu\n", n_in, ws_size); grid = -1; return; }
        int dev = 0, cus = 0, per_cu = 0;
        hipGetDevice(&dev); hipDeviceGetAttribute(&cus, hipDeviceAttributeMultiprocessorCount, dev);
        if (hipFuncSetAttribute((const void*)fwd_megakernel, hipFuncAttributeMaxDynamicSharedMemorySize, LDS_BYTES) != hipSuccess) { fprintf(stderr, "kernel_launch: hipFuncSetAttribute failed\n"); grid = -1; return; }
        if (hipOccupancyMaxActiveBlocksPerMultiprocessor(&per_cu, (const void*)fwd_megakernel, 512, LDS_BYTES) != hipSuccess || per_cu < 1) { fprintf(stderr, "kernel_launch: occupancy query says %d\n", per_cu); per_cu = 1; }
        (void)hipGetLastError();
        grid = cus * per_cu;
        fprintf(stderr, "kernel_launch: grid %d (cus %d x %d)\n", grid, cus, per_cu);
        if (grid < 256) { fprintf(stderr, "kernel_launch: this kernel needs at least 256 co-resident workgroups (64x64 sample tiles, scan items); nothing launched\n"); grid = -1; return; }
    }
    if (grid < 0) return;
    Args a{};
    for (int i = 0; i < 22; ++i) a.in[i] = (const float*)d_in[i];
    a.out = (float*)d_out; a.ws = (unsigned char*)d_ws;
    if (hipMemsetAsync((char*)d_ws + WS_BAR, 0, 32768, stream) != hipSuccess) { fprintf(stderr, "kernel_launch: memset of the barrier words failed\n"); return; }
    a.ph_lo = 0; a.ph_hi = 9 + (MK_DUP >= 0 ? 1 : 0);
    void* args[] = {&a};
    hipError_t e = hipLaunchCooperativeKernel((const void*)fwd_megakernel, dim3(grid), dim3(512), args, LDS_BYTES, stream);
    if (e != hipSuccess) fprintf(stderr, "cooperative launch failed: %s (grid %d)\n", hipGetErrorString(e), grid);
}
```

```cpp
#include <hip/hip_runtime.h>
#include <hip/hip_cooperative_groups.h>
#include <cstdio>
#include <cstdint>
namespace cg = cooperative_groups;
#ifndef MK_XABASE
#define MK_XABASE 1
#endif
#ifndef MK_DUP
#define MK_DUP -1
#endif

#define LAS __attribute__((address_space(3)))
typedef unsigned short bf16_t;
typedef short bf16x8 __attribute__((ext_vector_type(8)));
typedef float f32x4 __attribute__((ext_vector_type(4)));
typedef unsigned u32x4 __attribute__((ext_vector_type(4)));
typedef unsigned u32x2 __attribute__((ext_vector_type(2)));

__device__ __forceinline__ unsigned cvt_pk_bf16(float lo, float hi) { unsigned r; asm volatile("v_cvt_pk_bf16_f32 %0, %1, %2" : "=v"(r) : "v"(lo), "v"(hi)); return r; }
__device__ __forceinline__ float bf2f(unsigned h) { return __uint_as_float(h << 16); }
__device__ __forceinline__ float bflo(unsigned w) { return __uint_as_float(w << 16); }
__device__ __forceinline__ float bfhi(unsigned w) { return __uint_as_float(w & 0xffff0000u); }
__device__ __forceinline__ float sigmoidf_(float x) { return __builtin_amdgcn_rcpf(1.0f + __expf(-x)); }
__device__ __forceinline__ float siluf_(float x) { return x * sigmoidf_(x); }
__device__ __forceinline__ float ss_row(const float* ssb, size_t row, int q, int stride) {
    const f32x4 v = *(const f32x4*)(ssb + row * 16 + 4 * q);
    float s = (v.x + v.y) + (v.z + v.w);
    s += __shfl_xor(s, stride); s += __shfl_xor(s, 2 * stride);
    return s;
}
__device__ __forceinline__ void rs_rows(const float* ssb, int row0, int fq, float (&rs)[8]) {
    f32x4 v[8];
#pragma unroll
    for (int i = 0; i < 8; ++i) v[i] = *(const f32x4*)(ssb + (size_t)(row0 + (i >> 2) * 128 + (i & 3) * 16) * 16 + 4 * fq);
#pragma unroll
    for (int i = 0; i < 8; ++i) { float s = (v[i].x + v[i].y) + (v[i].z + v[i].w); s += __shfl_xor(s, 16); s += __shfl_xor(s, 32); rs[i] = __builtin_amdgcn_rsqf(s * (1.0f / 1024.0f) + 1e-6f); }
}
#define LBAR() do { asm volatile("s_waitcnt lgkmcnt(0)" ::: "memory"); __builtin_amdgcn_s_barrier(); asm volatile("" ::: "memory"); } while (0)

constexpr int MP = 32768, MS = 1024, MTOK = MP + MS, DM = 1024, FF = 2816, DIN = 3072, DC = 512, DH = 512;
constexpr int TP = 2048, TS = 64, NB = 16, CW = 31;
constexpr float EPS = 1e-6f;
constexpr size_t MiB = 1u << 20;
constexpr size_t WS_SS = 424 * MiB;
constexpr size_t WS_W13A = 2 * MiB, WS_W2A = 13 * MiB, WS_WIN = 19 * MiB, WS_WOUT = 25 * MiB, WS_W13B = 27 * MiB, WS_W2B = 38 * MiB;
constexpr size_t WS_XA = 44 * MiB, WS_H = 110 * MiB;
constexpr size_t WS_U = 110 * MiB, WS_Q = 143 * MiB, WS_K = 176 * MiB, WS_V = 209 * MiB, WS_G = 242 * MiB, WS_LF = 292 * MiB, WS_CR = 358 * MiB, WS_BAR = 434 * MiB, WS_END = 435 * MiB;
constexpr size_t OY = 0, OCP = (size_t)MTOK * DM, OHP = OCP + 16 * 30 * 512, OCS = OHP + 16 * 4 * 128 * 128, OHS = OCS + 16 * 30 * 512;
constexpr int LDS_BYTES = 147456;

struct Args { const float* in[22]; float* out; unsigned char* ws; int ph_lo, ph_hi; };
enum { I_XP = 0, I_XS, I_SCONV, I_SHGRN, I_N1, I_F1W1, I_F1W3, I_F1W2, I_NM, I_WIN, I_DWW, I_DWB, I_LNG, I_LNB, I_LOGITS, I_GN, I_WOUT, I_N2, I_F2W1, I_F2W3, I_F2W2, I_NF };

__device__ __forceinline__ unsigned char* ws_reload() {
    typedef unsigned char* ptr_t;
    const __attribute__((address_space(4))) char* ka = (const __attribute__((address_space(4))) char*)__builtin_amdgcn_kernarg_segment_ptr();
    return *(const volatile __attribute__((address_space(4))) ptr_t*)(ka + 22 * 8 + 8);
}

namespace pg8 {
constexpr int BM = 256, BK = 64, HALF = 128, HTB = HALF * BK * 2  , STAGE_BYTES = 8 * HTB, NXCD = 8, WGM = 8;
__host__ __device__ __forceinline__ int lds_byte(int r, int c) { const int st = (r >> 4) * 2 + (c >> 5), rr = r & 15, cc = c & 31, ob = rr * 64 + cc * 2; return st * 1024 + (ob ^ (((ob >> 9) & 1) << 5)); }
__host__ __device__ __forceinline__ void stage_rc(int b, int& R, int& C) { const int st = b / 1024, sb = b % 1024, swz = sb ^ (((sb >> 9) & 1) << 5); R = (st >> 1) * 16 + swz / 64; C = (st & 1) * 32 + (swz % 64) / 2; }
__host__ __device__ __forceinline__ int perm32(int rho) { const int n = rho >> 4, i = rho & 15; return 8 * (i >> 2) + 4 * n + (i & 3); }

struct Unit { int pm, pn; };
struct Gemm { const bf16_t* A; const bf16_t* Bt; int M, N, K; };

struct StaticOrder {
    int nM, nN, nwg, G, c;
    __host__ __device__ void init(int M, int N, int G_, int c_) { nM = M / BM; nN = N / BM; nwg = nM * nN; G = G_; c = c_; }
    __host__ __device__ bool next(int i, Unit& u) const {
        const long L = (long)i * G + c; if (L >= nwg) return false;
        int wgid = (int)L; { const int q = nwg / NXCD, r = nwg % NXCD, xcd = wgid % NXCD, off = wgid / NXCD; wgid = (xcd < r ? xcd * (q + 1) : r * (q + 1) + (xcd - r) * q) + off; }
        const int nig = WGM * nN, gid = wgid / nig, fm = gid * WGM, gsz = (nM - fm) < WGM ? (nM - fm) : WGM;
        u.pm = fm + ((wgid % nig) % gsz); u.pn = (wgid % nig) / gsz; return true;
    }
};

struct Epi { int kind, perm, ph, pn_off, pm_off; };

__device__ __forceinline__ void epi_swiglu(const Args& a, const Epi& E, const f32x4 (&acc)[2][2][4][2], const Unit& u, int wr, int wc, int fr, int fq, const LAS float* rst) {
    unsigned char* const wsl = ws_reload();
    asm volatile("" : "+v"(fr), "+v"(fq));
    const int row0 = u.pm * BM + wr * 64 + fr, col0 = u.pn * HALF + wc * 32 + 8 * fq;
    const float* ss_in = (const float*)(wsl + WS_SS) + (E.ph == 1 ? 0 : 2 * (size_t)MTOK * 16);
    bf16_t* Hh = (bf16_t*)(wsl + WS_H);
    float rs8[8];
#pragma unroll
    for (int i = 0; i < 8; ++i) rs8[i] = rst[(i >> 2) * HALF + wr * 64 + (i & 3) * 16 + fr];
#pragma unroll
    for (int ai = 0; ai < 2; ++ai)
#pragma unroll
        for (int m = 0; m < 4; ++m) {
            const int row = row0 + ai * HALF + m * 16;
            const float rs = rs8[ai * 4 + m];
            float h[8];
#pragma unroll
            for (int n = 0; n < 2; ++n)
#pragma unroll
                for (int j = 0; j < 4; ++j) { const float av = acc[ai][0][m][n][j] * rs, b = acc[ai][1][m][n][j] * rs; h[n * 4 + j] = siluf_(av) * b; }
            u32x4 w; w.x = cvt_pk_bf16(h[0], h[1]); w.y = cvt_pk_bf16(h[2], h[3]); w.z = cvt_pk_bf16(h[4], h[5]); w.w = cvt_pk_bf16(h[6], h[7]);
            *(u32x4*)(Hh + (size_t)row * FF + col0) = w;
        }
}

__device__ __forceinline__ void epi_resid(const Args& a, const Epi& E, const f32x4 (&acc)[2][2][4][2], const Unit& u, int wr, int wc, int fr, int fq) {
    unsigned char* const wsl = ws_reload();
    asm volatile("" : "+v"(fr), "+v"(fq));
    bf16_t* xa = (bf16_t*)(wsl + WS_XA);
    const float* xin = (u.pm < MP / BM) ? a.in[I_XP] + (size_t)u.pm * BM * DM : a.in[I_XS] + (size_t)(u.pm - MP / BM) * BM * DM;
    const float scale = (E.ph == 5) ? 1.0f : 0.5f;
    float* ss_out = (float*)(wsl + WS_SS) + (size_t)(E.ph == 2 ? 1 : (E.ph == 5 ? 2 : 3)) * MTOK * 16;
    const int col0 = u.pn * BM + wc * 32 + 8 * fq;
#pragma unroll
    for (int ai = 0; ai < 2; ++ai) {
        f32x4 bb[4][2][2];
        if (E.ph == 2 && !MK_XABASE) {
#pragma unroll
            for (int m = 0; m < 4; ++m)
#pragma unroll
                for (int bj = 0; bj < 2; ++bj)
#pragma unroll
                    for (int n = 0; n < 2; ++n) bb[m][bj][n] = *(const f32x4*)(xin + (size_t)(ai * HALF + wr * 64 + m * 16 + fr) * DM + col0 + bj * HALF + n * 4);
        } else {
            u32x4 rb[4][2];
#pragma unroll
            for (int m = 0; m < 4; ++m)
#pragma unroll
                for (int bj = 0; bj < 2; ++bj) rb[m][bj] = *(const u32x4*)(xa + ((size_t)u.pm * BM + ai * HALF + wr * 64 + m * 16 + fr) * DM + col0 + bj * HALF);
#pragma unroll
            for (int m = 0; m < 4; ++m)
#pragma unroll
                for (int bj = 0; bj < 2; ++bj) { const u32x4 r = rb[m][bj]; bb[m][bj][0] = (f32x4){bflo(r.x), bfhi(r.x), bflo(r.y), bfhi(r.y)}; bb[m][bj][1] = (f32x4){bflo(r.z), bfhi(r.z), bflo(r.w), bfhi(r.w)}; }
        }
#pragma unroll
        for (int m = 0; m < 4; ++m) {
            const int lr = ai * HALF + wr * 64 + m * 16 + fr; const size_t grow = (size_t)u.pm * BM + lr;
            float s = 0.f;
#pragma unroll
            for (int bj = 0; bj < 2; ++bj) {
                const f32x4 o0 = bb[m][bj][0] + acc[ai][bj][m][0] * scale, o1 = bb[m][bj][1] + acc[ai][bj][m][1] * scale;
                u32x4 w; w.x = cvt_pk_bf16(o0[0], o0[1]); w.y = cvt_pk_bf16(o0[2], o0[3]); w.z = cvt_pk_bf16(o1[0], o1[1]); w.w = cvt_pk_bf16(o1[2], o1[3]);
                *(u32x4*)(xa + grow * DM + col0 + bj * HALF) = w;
                s += ((o0[0] * o0[0] + o0[1] * o0[1]) + (o0[2] * o0[2] + o0[3] * o0[3])) + ((o1[0] * o1[0] + o1[1] * o1[1]) + (o1[2] * o1[2] + o1[3] * o1[3]));
            }
            s += __shfl_xor(s, 16); s += __shfl_xor(s, 32);
            if (fq == 0) ss_out[grow * 16 + u.pn * 4 + wc] = s;
        }
        asm volatile("" ::: "memory");
    }
}

__device__ __forceinline__ void epi_mix(const Args& a, const Epi& E, const f32x4 (&acc)[2][2][4][2], const Unit& u, int wr, int wc, int fr, int fq, const LAS float* rst) {
    unsigned char* const wsl = ws_reload();
    asm volatile("" : "+v"(fr), "+v"(fq));
    const int pmg = u.pm + E.pm_off;
    const int row0 = pmg * BM + wr * 64 + fr;
    const float* ss_in = (const float*)(wsl + WS_SS) + (size_t)MTOK * 16;
    float rs8[8];
#pragma unroll
    for (int i = 0; i < 8; ++i) rs8[i] = rst[(i >> 2) * HALF + wr * 64 + (i & 3) * 16 + fr];
    const int pn = u.pn + E.pn_off;
    if (pn < 4) {
        const int ch0 = pn * HALF + wc * 32 + 8 * fq;
#pragma unroll
        for (int ai = 0; ai < 2; ++ai)
#pragma unroll
            for (int m = 0; m < 4; ++m) {
                const int row = row0 + ai * HALF + m * 16;
                const float rs = rs8[ai * 4 + m];
                float h[8];
#pragma unroll
                for (int n = 0; n < 2; ++n)
#pragma unroll
                    for (int j = 0; j < 4; ++j) { const float a = acc[ai][0][m][n][j] * rs, g = acc[ai][1][m][n][j] * rs; h[n * 4 + j] = a * sigmoidf_(g); }
                u32x4 w; w.x = cvt_pk_bf16(h[0], h[1]); w.y = cvt_pk_bf16(h[2], h[3]); w.z = cvt_pk_bf16(h[4], h[5]); w.w = cvt_pk_bf16(h[6], h[7]);
                *(u32x4*)((bf16_t*)(wsl + WS_U) + (size_t)row * DC + ch0) = w;
                const bool samp = pmg >= MP / BM;
                const int r2 = samp ? row - MP : row, sh = samp ? 6 : 11, T = samp ? TS : TP, seq = r2 >> sh, t = r2 & (T - 1);
                const size_t obase = samp ? OCS : OCP;
                if (t >= T - 30) { float* d = a.out + obase + ((size_t)(seq * 30 + (t - (T - 30))) * DC + ch0);
                    *(f32x4*)d = (f32x4){h[0], h[1], h[2], h[3]}; *(f32x4*)(d + 4) = (f32x4){h[4], h[5], h[6], h[7]}; }
                asm volatile("" ::: "memory");
            }
    } else {
        const int typ = (pn - 4) >> 1;
        const size_t dsto = typ == 0 ? WS_Q : typ == 1 ? WS_K : typ == 2 ? WS_V : WS_G;
        bf16_t* dstb = (bf16_t*)(wsl + dsto);
#pragma unroll
        for (int bj = 0; bj < 2; ++bj) {
            const int cc0 = ((pn - 4) & 1) * BM + bj * HALF + wc * 32 + 8 * fq;
            f32x4 aux[2] = {(f32x4){0.f, 0.f, 0.f, 0.f}, (f32x4){0.f, 0.f, 0.f, 0.f}};
            if (typ == 1) {
#pragma unroll
                for (int n = 0; n < 2; ++n) { const f32x4 l0 = *(const f32x4*)(a.in[I_LOGITS] + cc0 + 4 * n), l1 = *(const f32x4*)(a.in[I_LOGITS] + DH + cc0 + 4 * n);
#pragma unroll
                    for (int j = 0; j < 4; ++j) aux[n][j] = sigmoidf_(l0[j] - l1[j]); }
            } else if (typ == 3) { aux[0] = *(const f32x4*)(a.in[I_GN] + cc0); aux[1] = *(const f32x4*)(a.in[I_GN] + cc0 + 4); }
#pragma unroll
            for (int ai = 0; ai < 2; ++ai)
#pragma unroll
                for (int m = 0; m < 4; ++m) {
                    const int row = row0 + ai * HALF + m * 16;
                    const float rs = rs8[ai * 4 + m];
                    u32x4 w;
#pragma unroll
                    for (int n = 0; n < 2; ++n) {
                        const f32x4 v = acc[ai][bj][m][n] * rs;
                        f32x4 h;
                        if (typ == 0) {
#pragma unroll
                            for (int j = 0; j < 4; ++j) h[j] = siluf_(v[j]);
                        } else if (typ == 1) { f32x4 lf;
#pragma unroll
                            for (int j = 0; j < 4; ++j) { const float sg = sigmoidf_(v[j]); lf[j] = __logf(aux[n][j] + (1.0f - aux[n][j]) * sg); h[j] = (1.0f - aux[n][j]) * (1.0f - sg); }
                            *(f32x4*)((float*)(wsl + WS_LF) + (size_t)row * DH + cc0 + 4 * n) = lf;
                        } else if (typ == 2) h = v;
                        else {
#pragma unroll
                            for (int j = 0; j < 4; ++j) h[j] = aux[n][j] * siluf_(v[j]);
                        }
                        if (n == 0) { w.x = cvt_pk_bf16(h[0], h[1]); w.y = cvt_pk_bf16(h[2], h[3]); } else { w.z = cvt_pk_bf16(h[0], h[1]); w.w = cvt_pk_bf16(h[2], h[3]); }
                    }
                    *(u32x4*)(dstb + (size_t)row * DH + cc0) = w;
                    asm volatile("" ::: "memory");
                }
        }
    }
}

__device__ __forceinline__ void gemm_phase(const Args& a, LAS unsigned char* lds, const Gemm g, const StaticOrder& S, const Epi& E, const int wid0) {
    int tid = wid0 * 64 + (int)__builtin_amdgcn_mbcnt_hi(~0u, __builtin_amdgcn_mbcnt_lo(~0u, 0u)); asm volatile("" : "+v"(tid));
    const int wid = __builtin_amdgcn_readfirstlane(tid >> 6), lane = tid & 63, wr = wid >> 2, wc = wid & 3, fr = lane & 15, fq = lane >> 4;
    const int K = g.K, nt = K / BK;
    unsigned voffA[2], voffB[2];
#pragma unroll
    for (int i = 0; i < 2; ++i) { int R, C; stage_rc(tid * 16 + i * 8192, R, C); const int Rb = E.perm ? ((R & ~31) + perm32(R & 31)) : R;
        voffA[i] = (unsigned)(R * K + C) * 2u; voffB[i] = (unsigned)(Rb * K + C) * 2u; }
    const size_t kstep = (size_t)(BK * 2);
    const size_t hstep = (size_t)HALF * K * 2;
    const size_t tstep = 2 * hstep;
    const unsigned ldsw = (unsigned)wid * 1024u;
    const int aoff = lds_byte(wr * 64 + fr, fq * 8), boff = lds_byte(wc * 32 + fr, fq * 8);
#define PG8_SA(b, h) (((b) * 2 + (h)) * HTB)
#define PG8_SB(b, h) ((4 + (b) * 2 + (h)) * HTB)
#define PG8_STAGE(bufoff, gbase, voff) do { _Pragma("unroll") for (int _i = 0; _i < 2; ++_i) \
        __builtin_amdgcn_global_load_lds((const unsigned*)((const char*)(gbase) + (voff)[_i]), (LAS unsigned*)(lds + (bufoff) + ldsw + _i * 8192), 16, 0, 0); } while (0)
#define PG8_LDA(dst, b, h) do { _Pragma("unroll") for (int m = 0; m < 4; ++m) _Pragma("unroll") for (int k = 0; k < 2; ++k) dst[m][k] = *(const LAS bf16x8*)(lds + PG8_SA(b, h) + aoff + m * 2048 + k * 1024); } while (0)
#define PG8_LDB(dst, b, h) do { _Pragma("unroll") for (int n = 0; n < 2; ++n) _Pragma("unroll") for (int k = 0; k < 2; ++k) dst[n][k] = *(const LAS bf16x8*)(lds + PG8_SB(b, h) + boff + n * 2048 + k * 1024); } while (0)
#define PG8_MMA(ai, bj, At, Bt) do { __builtin_amdgcn_s_setprio(1); _Pragma("unroll") for (int m = 0; m < 4; ++m) _Pragma("unroll") for (int n = 0; n < 2; ++n) _Pragma("unroll") for (int k = 0; k < 2; ++k) \
        acc[ai][bj][m][n] = __builtin_amdgcn_mfma_f32_16x16x32_bf16(Bt[n][k], At[m][k], acc[ai][bj][m][n], 0, 0, 0); __builtin_amdgcn_s_setprio(0); } while (0)
#define PG8_WAIT_V(n) asm volatile("s_waitcnt vmcnt(" #n ")" ::: "memory")
#define PG8_WAIT_L(n) asm volatile("s_waitcnt lgkmcnt(" #n ")" ::: "memory")
#define PG8_BAR __builtin_amdgcn_s_barrier()
#define PG8_SCHED __builtin_amdgcn_sched_barrier(0)
    Unit cur, nxt; int ui = 0;
    if (!S.next(0, cur)) return;
    LAS float* rstab = (LAS float*)(lds + STAGE_BYTES);
    if (E.kind != 1) {
        const float* ssb = (const float*)(ws_reload() + WS_SS) + (E.kind == 2 ? (size_t)MTOK * 16 : (E.ph == 1 ? 0 : 2 * (size_t)MTOK * 16));
        for (int j = tid; ; j += 512) { Unit uu; if (!S.next(j >> 8, uu)) break;
            const f32x4* p = (const f32x4*)(ssb + ((size_t)(uu.pm + (E.kind == 2 ? E.pm_off : 0)) * BM + (j & 255)) * 16); const f32x4 x0 = p[0], x1 = p[1], x2 = p[2], x3 = p[3];
            const float s = (((x0.x + x0.y) + (x0.z + x0.w)) + ((x1.x + x1.y) + (x1.z + x1.w))) + (((x2.x + x2.y) + (x2.z + x2.w)) + ((x3.x + x3.y) + (x3.z + x3.w)));
            rstab[j] = __builtin_amdgcn_rsqf(s * (1.0f / 1024.0f) + 1e-6f); }
        asm volatile("s_waitcnt vmcnt(0) lgkmcnt(0)" ::: "memory"); __builtin_amdgcn_s_barrier(); asm volatile("" ::: "memory");
    }
    f32x4 acc[2][2][4][2];
#pragma unroll
    for (int a = 0; a < 2; ++a)
#pragma unroll
        for (int b = 0; b < 2; ++b)
#pragma unroll
            for (int m = 0; m < 4; ++m)
#pragma unroll
                for (int n = 0; n < 2; ++n) acc[a][b][m][n] = (f32x4){0.f, 0.f, 0.f, 0.f};
    bf16x8 At[4][2], B0[2][2], B1[2][2];
    const char* cA = (const char*)g.A + (size_t)cur.pm * tstep; const char* cB = (const char*)g.Bt + (size_t)cur.pn * tstep;
    PG8_STAGE(PG8_SB(0, 0), cB, voffB); PG8_STAGE(PG8_SB(0, 1), cB + hstep, voffB); PG8_STAGE(PG8_SA(0, 0), cA, voffA); PG8_STAGE(PG8_SA(0, 1), cA + hstep, voffA);
    if (wr == 1) PG8_BAR;
    PG8_WAIT_V(2); PG8_BAR;
    PG8_STAGE(PG8_SB(1, 0), cB + kstep, voffB); PG8_STAGE(PG8_SA(1, 0), cA + kstep, voffA); PG8_STAGE(PG8_SB(1, 1), cB + hstep + kstep, voffB);
    PG8_WAIT_V(6); PG8_BAR;
    for (;;) {
        const bool has_next = S.next(ui + 1, nxt);
        const char* nA = has_next ? (const char*)g.A + (size_t)nxt.pm * tstep : cA; const char* nB = has_next ? (const char*)g.Bt + (size_t)nxt.pn * tstep : cB;
        for (int t = 0; t < nt; t += 2) {
            const bool last = (t == nt - 2);
            const char* a1 = cA + (size_t)(t + 1) * kstep;
            const char* a2 = last ? nA : cA + (size_t)(t + 2) * kstep; const char* b2 = last ? nB : cB + (size_t)(t + 2) * kstep;
            const char* a3 = a2 + kstep; const char* b3 = b2 + kstep;
            PG8_LDB(B0, 0, 0); PG8_LDB(B1, 0, 1); PG8_SCHED; PG8_LDA(At, 0, 0); PG8_STAGE(PG8_SA(1, 1), a1 + hstep, voffA);
            PG8_WAIT_V(8); PG8_WAIT_L(0); PG8_BAR; PG8_MMA(0, 0, At, B0); PG8_MMA(0, 1, At, B1); PG8_BAR; PG8_SCHED;
            PG8_LDA(At, 0, 1); PG8_STAGE(PG8_SB(0, 0), b2, voffB); PG8_STAGE(PG8_SB(0, 1), b2 + hstep, voffB); PG8_STAGE(PG8_SA(0, 0), a2, voffA);
            PG8_WAIT_V(8); PG8_WAIT_L(0); PG8_BAR; PG8_MMA(1, 0, At, B0); PG8_MMA(1, 1, At, B1); PG8_BAR; PG8_SCHED;
            PG8_LDB(B0, 1, 0); PG8_LDB(B1, 1, 1); PG8_SCHED; PG8_LDA(At, 1, 0); PG8_STAGE(PG8_SA(0, 1), a2 + hstep, voffA);
            PG8_WAIT_V(8); PG8_WAIT_L(0); PG8_BAR; PG8_MMA(0, 0, At, B0); PG8_MMA(0, 1, At, B1); PG8_BAR; PG8_SCHED;
            PG8_LDA(At, 1, 1); PG8_STAGE(PG8_SB(1, 0), b3, voffB); PG8_STAGE(PG8_SB(1, 1), b3 + hstep, voffB); PG8_STAGE(PG8_SA(1, 0), a3, voffA);
            PG8_WAIT_V(8); PG8_WAIT_L(0); PG8_BAR; PG8_MMA(1, 0, At, B0); PG8_MMA(1, 1, At, B1); PG8_BAR; PG8_SCHED;
        }
        if (wr == 0) PG8_BAR;
        if (E.kind == 0) epi_swiglu(a, E, acc, cur, wr, wc, fr, fq, rstab + ui * 256);
        else if (E.kind == 1) epi_resid(a, E, acc, cur, wr, wc, fr, fq);
        else epi_mix(a, E, acc, cur, wr, wc, fr, fq, rstab + ui * 256);
        if (!has_next) break;
#pragma unroll
        for (int a = 0; a < 2; ++a)
#pragma unroll
            for (int b = 0; b < 2; ++b)
#pragma unroll
                for (int m = 0; m < 4; ++m)
#pragma unroll
                    for (int n = 0; n < 2; ++n) acc[a][b][m][n] = (f32x4){0.f, 0.f, 0.f, 0.f};
        cur = nxt; cA = nA; cB = nB; ++ui;
        if (wr == 1) PG8_BAR;
    }
    PG8_WAIT_V(0);
    PG8_BAR;
#undef PG8_SA
#undef PG8_SB
#undef PG8_STAGE
#undef PG8_LDA
#undef PG8_LDB
#undef PG8_MMA
#undef PG8_WAIT_V
#undef PG8_WAIT_L
#undef PG8_BAR
#undef PG8_SCHED
}
}


__device__ __forceinline__ float wave_sum(float v) {
#pragma unroll
    for (int o = 1; o < 64; o <<= 1) v += __shfl_xor(v, o);
    return v;
}

__device__ __forceinline__ void p0_transpose_item(const float* W, int K, int Nsrc, int src_col0, const float* gs, bf16_t* WT, int dst_row0, LAS float* scr, int kb, int lane) {
    const int k0 = 64 * kb, r = lane >> 4, c4 = lane & 15;
    f32x4 v[16];
#pragma unroll
    for (int i = 0; i < 16; ++i) v[i] = *(const f32x4*)(W + (size_t)(k0 + 4 * i + r) * Nsrc + src_col0 + 4 * c4);
#pragma unroll
    for (int i = 0; i < 16; ++i) { const float g = gs ? gs[k0 + 4 * i + r] : 1.0f; LAS float* p = scr + (4 * i + r) * 65 + 4 * c4; p[0] = v[i].x * g; p[1] = v[i].y * g; p[2] = v[i].z * g; p[3] = v[i].w * g; }
    asm volatile("s_waitcnt lgkmcnt(0)" ::: "memory");
    const int c = lane & 7;
#pragma unroll
    for (int j = 0; j < 8; ++j) { const int n = (lane >> 3) + 8 * j; const LAS float* s = scr + (8 * c) * 65 + n;
        u32x4 o; o.x = cvt_pk_bf16(s[0 * 65], s[1 * 65]); o.y = cvt_pk_bf16(s[2 * 65], s[3 * 65]); o.z = cvt_pk_bf16(s[4 * 65], s[5 * 65]); o.w = cvt_pk_bf16(s[6 * 65], s[7 * 65]);
        *(u32x4*)(WT + (size_t)(dst_row0 + n) * K + k0 + 8 * c) = o; }
    asm volatile("s_waitcnt lgkmcnt(0)" ::: "memory");
}

__device__ __forceinline__ void p0_weights(const Args& a, LAS unsigned char* lds, int it_lo, int it_hi, int gw, int NGW, const int wid0) {
    unsigned char* const wsl = ws_reload();
    int tid = wid0 * 64 + (int)__builtin_amdgcn_mbcnt_hi(~0u, __builtin_amdgcn_mbcnt_lo(~0u, 0u)); asm volatile("" : "+v"(tid));
    const int lane = tid & 63, wave = tid >> 6;
    LAS float* scr = (LAS float*)(lds + wave * 16896);
    unsigned char* ws = wsl;
    constexpr int N13 = 2 * FF / 64, K13 = DM / 64, I13 = N13 * K13;
    constexpr int N2 = DM / 64, K2 = FF / 64, I2 = N2 * K2;
    constexpr int NIN = DIN / 64, KIN = DM / 64, IIN = NIN * KIN;
    constexpr int NO = DM / 64, KO = DM / 64, IO = NO * KO;
    constexpr int NITEMS = 2 * I13 + 2 * I2 + IIN + IO;
    static_assert(NITEMS == 5248 && I13 == 1408, "item map");
    for (int it = it_lo + gw; it < it_hi; it += NGW) {
        int r = it;
        if (r < 2 * I13) { const int which = r / I13; r -= which * I13; const int nb = r / K13, kb = r % K13, n0 = nb * 64, p = n0 >> 8, within = n0 & 255;
            const float* W = (within < 128) ? a.in[which ? I_F2W1 : I_F1W1] : a.in[which ? I_F2W3 : I_F1W3];
            p0_transpose_item(W, DM, FF, 128 * p + (within & 127), a.in[which ? I_N2 : I_N1], (bf16_t*)(ws + (which ? WS_W13B : WS_W13A)), n0, scr, kb, lane); continue; }
        r -= 2 * I13;
        if (r < 2 * I2) { const int which = r / I2; r -= which * I2; const int nb = r / K2, kb = r % K2;
            p0_transpose_item(a.in[which ? I_F2W2 : I_F1W2], FF, DM, nb * 64, nullptr, (bf16_t*)(ws + (which ? WS_W2B : WS_W2A)), nb * 64, scr, kb, lane); continue; }
        r -= 2 * I2;
        if (r < IIN) { const int nb = r / KIN, kb = r % KIN, n0 = nb * 64; int srcc;
            if (n0 < 1024) { const int p = n0 >> 8, within = n0 & 255; srcc = (within < 128) ? 128 * p + within : 512 + 128 * p + (within - 128); } else srcc = n0;
            p0_transpose_item(a.in[I_WIN], DM, DIN, srcc, a.in[I_NM], (bf16_t*)(ws + WS_WIN), n0, scr, kb, lane); continue; }
        r -= IIN;
        { const int nb = r / KO, kb = r % KO; p0_transpose_item(a.in[I_WOUT], DM, DM, nb * 64, nullptr, (bf16_t*)(ws + WS_WOUT), nb * 64, scr, kb, lane); }
    }
}
__device__ __forceinline__ void p0_rows(const Args& a, int G, const int wid0) {
    unsigned char* const wsl = ws_reload();
    int tid = wid0 * 64 + (int)__builtin_amdgcn_mbcnt_hi(~0u, __builtin_amdgcn_mbcnt_lo(~0u, 0u)); asm volatile("" : "+v"(tid));
    const int lane = tid & 63, wave = tid >> 6;
    const int gw = blockIdx.x * 8 + wave, NGW = G * 8;
    unsigned char* ws = wsl;
    float* ss = (float*)(ws + WS_SS); bf16_t* XA = (bf16_t*)(ws + WS_XA);
    for (int m0 = gw; m0 < MTOK; m0 += 4 * NGW) {
        f32x4 v[4][4];
#pragma unroll
        for (int q = 0; q < 4; ++q) { const int m = m0 + q * NGW; if (m < MTOK) { const float* xr = (m < MP) ? a.in[I_XP] + (size_t)m * DM : a.in[I_XS] + (size_t)(m - MP) * DM;
#pragma unroll
            for (int j = 0; j < 4; ++j) v[q][j] = __builtin_nontemporal_load((const f32x4*)xr + lane + 64 * j); } }
#pragma unroll
        for (int q = 0; q < 4; ++q) { const int m = m0 + q * NGW; if (m < MTOK) {
            float s = 0.f;
#pragma unroll
            for (int j = 0; j < 4; ++j) s += (v[q][j].x * v[q][j].x + v[q][j].y * v[q][j].y) + (v[q][j].z * v[q][j].z + v[q][j].w * v[q][j].w);
            s = wave_sum(s);
            u32x2* o = (u32x2*)(XA + (size_t)m * DM);
#pragma unroll
            for (int j = 0; j < 4; ++j) { u32x2 w; w.x = cvt_pk_bf16(v[q][j].x, v[q][j].y); w.y = cvt_pk_bf16(v[q][j].z, v[q][j].w); o[lane + 64 * j] = w; }
            if (lane < 16) ss[(size_t)m * 16 + lane] = (lane == 0) ? s : 0.f; } }
    }
}

__device__ __forceinline__ void p8_final(const Args& a, int G, const int wid0) {
    unsigned char* const wsl = ws_reload();
    int tid = wid0 * 64 + (int)__builtin_amdgcn_mbcnt_hi(~0u, __builtin_amdgcn_mbcnt_lo(~0u, 0u)); asm volatile("" : "+v"(tid));
    const int lane = tid & 63, wave = tid >> 6;
    const int gw = blockIdx.x * 8 + wave, NGW = G * 8;
    const float* ss3 = (const float*)(wsl + WS_SS) + (size_t)3 * MTOK * 16;
    f32x4 g[4];
#pragma unroll
    for (int j = 0; j < 4; ++j) g[j] = ((const f32x4*)a.in[I_NF])[lane + 64 * j];
    for (int m = gw; m < MTOK; m += NGW) {
        f32x4* yr = (f32x4*)(a.out + OY + (size_t)m * DM);
        const u32x2* xr = (const u32x2*)((const bf16_t*)(wsl + WS_XA) + (size_t)m * DM);
        u32x2 xv[4];
#pragma unroll
        for (int j = 0; j < 4; ++j) xv[j] = xr[lane + 64 * j];
        const float rs = __builtin_amdgcn_rsqf(ss_row(ss3, (size_t)m, lane & 3, 1) * (1.0f / DM) + EPS);
#pragma unroll
        for (int j = 0; j < 4; ++j) { const f32x4 v = (f32x4){bflo(xv[j].x), bfhi(xv[j].x), bflo(xv[j].y), bfhi(xv[j].y)}; __builtin_nontemporal_store(v * rs * g[j], yr + lane + 64 * j); }
    }
}

constexpr int CV_TT = 32, CV_WIN = CV_TT + 30, CV_YOFF = CV_WIN * DC * 2, CV_YLD = DC + 4, CV_NITEMS = NB * (TP / CV_TT) + NB * (TS / CV_TT);
static_assert(CV_YOFF + CV_TT * CV_YLD * 4 <= LDS_BYTES, "conv LDS");
typedef float f32x2c __attribute__((ext_vector_type(2)));
__device__ __forceinline__ void conv_decode(int item, int& seq, int& t0, int& rowbase, bool& sample) {
    if (item < NB * (TP / CV_TT)) { seq = item / (TP / CV_TT); t0 = (item % (TP / CV_TT)) * CV_TT; rowbase = seq * TP; sample = false; }
    else { const int j = item - NB * (TP / CV_TT); seq = j / (TS / CV_TT); t0 = (j % (TS / CV_TT)) * CV_TT; rowbase = MP + seq * TS; sample = true; }
}
__device__ __forceinline__ void conv_load(u32x4 (&W)[8], const Args& a, int item, int tid) {
    unsigned char* const wsl = ws_reload();
    int seq, t0, rowbase; bool sample; conv_decode(item, seq, t0, rowbase, sample);
    const bf16_t* U = (const bf16_t*)(wsl + WS_U);
#pragma unroll
    for (int p = 0; p < 8; ++p) {
        const int idx = tid + 512 * p, i = idx >> 6, ch = (idx & 63) * 8, t = t0 - 30 + i;
        u32x4 v = (u32x4){0u, 0u, 0u, 0u};
        if (idx < CV_WIN * (DC / 8)) {
            if (t >= 0) v = *(const u32x4*)(U + (size_t)(rowbase + t) * DC + ch);
            else if (sample) { const float* s = a.in[I_SCONV] + ((size_t)(seq * 30 + 30 + t) * DC + ch); const f32x4 s0 = *(const f32x4*)s, s1 = *(const f32x4*)(s + 4);
                v.x = cvt_pk_bf16(s0.x, s0.y); v.y = cvt_pk_bf16(s0.z, s0.w); v.z = cvt_pk_bf16(s1.x, s1.y); v.w = cvt_pk_bf16(s1.z, s1.w); }
        }
        W[p] = v;
    }
}
__device__ __forceinline__ void conv_items(const Args& a, LAS unsigned char* lds, int first, int stride, const int wid0) {
    unsigned char* const wsl = ws_reload();
    int tid = wid0 * 64 + (int)__builtin_amdgcn_mbcnt_hi(~0u, __builtin_amdgcn_mbcnt_lo(~0u, 0u)); asm volatile("" : "+v"(tid));
    const int lane = tid & 63, wave = tid >> 6;
    if (first >= CV_NITEMS) return;
    bf16_t* CR = (bf16_t*)(wsl + WS_CR);
    const int cp = tid & 255, th = tid >> 8;
    f32x2c w2[CW];
#pragma unroll
    for (int j = 0; j < CW; ++j) w2[j] = *(const f32x2c*)(a.in[I_DWW] + j * DC + 2 * cp);
    const f32x2c bias2 = *(const f32x2c*)(a.in[I_DWB] + 2 * cp);
    const f32x4 g0 = *(const f32x4*)(a.in[I_LNG] + lane * 8), g1 = *(const f32x4*)(a.in[I_LNG] + lane * 8 + 4);
    const f32x4 b0 = *(const f32x4*)(a.in[I_LNB] + lane * 8), b1 = *(const f32x4*)(a.in[I_LNB] + lane * 8 + 4);
    u32x4 W[8];
    conv_load(W, a, first, tid);
    for (int item = first; item < CV_NITEMS; item += stride) {
        int seq, t0, rowbase; bool sample; conv_decode(item, seq, t0, rowbase, sample);
#pragma unroll
        for (int p = 0; p < 8; ++p) { const int idx = tid + 512 * p; if (idx < CV_WIN * (DC / 8)) *(LAS u32x4*)(lds + (size_t)idx * 16) = W[p]; }
        LBAR();
        if (item + stride < CV_NITEMS) conv_load(W, a, item + stride, tid);
        f32x2c acc[16];
#pragma unroll
        for (int t = 0; t < 16; ++t) acc[t] = bias2;
#pragma unroll
        for (int i = 0; i < 46; ++i) {
            const unsigned xw = *(const LAS unsigned*)(lds + ((th * 16 + i) * DC + 2 * cp) * 2);
            const f32x2c x2 = (f32x2c){bflo(xw), bfhi(xw)};
#pragma unroll
            for (int t = 0; t < 16; ++t) if (i - t >= 0 && i - t < CW) acc[t] = acc[t] + x2 * w2[i - t];
        }
        LAS float* yb = (LAS float*)(lds + CV_YOFF);
#pragma unroll
        for (int t = 0; t < 16; ++t) *(LAS f32x2c*)(yb + (th * 16 + t) * CV_YLD + 2 * cp) = acc[t];
        LBAR();
#pragma unroll
        for (int q = 0; q < 4; ++q) {
            const int tt = wave * 4 + q;
            const f32x4 y0 = *(const LAS f32x4*)(yb + tt * CV_YLD + lane * 8), y1 = *(const LAS f32x4*)(yb + tt * CV_YLD + lane * 8 + 4);
            const float mu = wave_sum((y0.x + y0.y) + (y0.z + y0.w) + (y1.x + y1.y) + (y1.z + y1.w)) * (1.0f / DC);
            const f32x4 d0 = y0 - mu, d1 = y1 - mu;
            const float var = wave_sum((d0.x * d0.x + d0.y * d0.y) + (d0.z * d0.z + d0.w * d0.w) + (d1.x * d1.x + d1.y * d1.y) + (d1.z * d1.z + d1.w * d1.w)) * (1.0f / DC);
            const float rs = __builtin_amdgcn_rsqf(var + EPS);
            const f32x4 z0 = d0 * rs * g0 + b0, z1 = d1 * rs * g1 + b1;
            u32x4 o; o.x = cvt_pk_bf16(siluf_(z0.x), siluf_(z0.y)); o.y = cvt_pk_bf16(siluf_(z0.z), siluf_(z0.w)); o.z = cvt_pk_bf16(siluf_(z1.x), siluf_(z1.y)); o.w = cvt_pk_bf16(siluf_(z1.z), siluf_(z1.w));
            *(u32x4*)(CR + (size_t)(rowbase + t0 + tt) * DM + lane * 8) = o;
        }
        LBAR();
    }
}

constexpr int SC_QS = 0, SC_QE = 17408, SC_KE = 34816, SC_KET = 52224, SC_VT = 70656, SC_P = 89088, SC_SEG = 98304, SC_DEC = 102400, SC_OB = 103424, SC_ENDB = SC_OB + 64 * 132 * 4;
constexpr int SC_LD = 272, SC_LDT = 144, SC_OLD = 132;
static_assert(SC_ENDB <= LDS_BYTES - 64, "scan LDS");
typedef float f32x2 __attribute__((ext_vector_type(2)));
struct ScanRaw { f32x2 lf[8]; unsigned q[8], k[8], v[8]; };
__device__ __forceinline__ void scan_load(ScanRaw& r, const float* LF, const bf16_t* Qb, const bf16_t* Kb, const bf16_t* Vb, size_t row0, int col) {
#pragma unroll
    for (int i = 0; i < 8; ++i) { const size_t o = (row0 + i) * DH + col; r.lf[i] = *(const f32x2*)(LF + o); r.q[i] = *(const unsigned*)(Qb + o); r.k[i] = *(const unsigned*)(Kb + o); r.v[i] = *(const unsigned*)(Vb + o); }
}
__device__ __forceinline__ void scan_item(const Args& a, LAS unsigned char* lds, bool sample, int seq, int h, const int wid0) {
    unsigned char* const wsl = ws_reload();
    int tid = wid0 * 64 + (int)__builtin_amdgcn_mbcnt_hi(~0u, __builtin_amdgcn_mbcnt_lo(~0u, 0u)); asm volatile("" : "+v"(tid));
    const int lane = tid & 63, w = __builtin_amdgcn_readfirstlane(tid >> 6), l15 = lane & 15, quad = lane >> 4;
    const int T = sample ? TS : TP, rowbase = sample ? MP + seq * TS : seq * TP, nchunk = T / 64;
    const bf16_t* Qb = (const bf16_t*)(wsl + WS_Q); const bf16_t* Kb = (const bf16_t*)(wsl + WS_K); const bf16_t* Vb = (const bf16_t*)(wsl + WS_V); const bf16_t* Gb = (const bf16_t*)(wsl + WS_G);
    const float* LF = (const float*)(wsl + WS_LF); bf16_t* CR = (bf16_t*)(wsl + WS_CR);
    const int kp = lane, seg = w, col = h * 128 + 2 * kp;
    f32x4 sacc[8];
    if (sample) { const float* s0 = a.in[I_SHGRN] + (size_t)(seq * 4 + h) * 128 * 128;
#pragma unroll
        for (int kb = 0; kb < 8; ++kb)
#pragma unroll
            for (int j = 0; j < 4; ++j) sacc[kb][j] = s0[(size_t)(16 * kb + 4 * quad + j) * 128 + 16 * w + l15];
    } else {
#pragma unroll
        for (int kb = 0; kb < 8; ++kb) sacc[kb] = (f32x4){0.f, 0.f, 0.f, 0.f};
    }
    LAS f32x2* segs = (LAS f32x2*)(lds + SC_SEG); LAS float* dec = (LAS float*)(lds + SC_DEC); LAS float* ob = (LAS float*)(lds + SC_OB);
    const int ot = tid >> 3, ov0 = (tid & 7) * 16;
    bool pend = false; size_t p_orow = 0; u32x4 p_g0 = (u32x4){0u, 0u, 0u, 0u}, p_g1 = p_g0;
    ScanRaw R;
    scan_load(R, LF, Qb, Kb, Vb, (size_t)rowbase + seg * 8, col);
    for (int c = 0; c < nchunk; ++c) {
        f32x2 cs[8]; f32x2 run = (f32x2){0.f, 0.f};
#pragma unroll
        for (int i = 0; i < 8; ++i) { run = run + R.lf[i]; cs[i] = run; }
        segs[seg * 64 + kp] = run;
        LBAR();
        if (pend) {
            const size_t orow = p_orow; const u32x4 gq0 = p_g0, gq1 = p_g1;
            {
                f32x4 o[4]; float sq = 0.f;
#pragma unroll
                for (int i = 0; i < 4; ++i) { o[i] = *(const LAS f32x4*)(ob + ot * SC_OLD + ov0 + 4 * i); sq += (o[i].x * o[i].x + o[i].y * o[i].y) + (o[i].z * o[i].z + o[i].w * o[i].w); }
                sq += __shfl_xor(sq, 1); sq += __shfl_xor(sq, 2); sq += __shfl_xor(sq, 4);
                const float rs = __builtin_amdgcn_rsqf(sq * (1.0f / 128.0f) + EPS);
                u32x4 r0v, r1v;
                r0v.x = cvt_pk_bf16(o[0].x * rs * bflo(gq0.x), o[0].y * rs * bfhi(gq0.x)); r0v.y = cvt_pk_bf16(o[0].z * rs * bflo(gq0.y), o[0].w * rs * bfhi(gq0.y));
                r0v.z = cvt_pk_bf16(o[1].x * rs * bflo(gq0.z), o[1].y * rs * bfhi(gq0.z)); r0v.w = cvt_pk_bf16(o[1].z * rs * bflo(gq0.w), o[1].w * rs * bfhi(gq0.w));
                r1v.x = cvt_pk_bf16(o[2].x * rs * bflo(gq1.x), o[2].y * rs * bfhi(gq1.x)); r1v.y = cvt_pk_bf16(o[2].z * rs * bflo(gq1.y), o[2].w * rs * bfhi(gq1.y));
                r1v.z = cvt_pk_bf16(o[3].x * rs * bflo(gq1.z), o[3].y * rs * bfhi(gq1.z)); r1v.w = cvt_pk_bf16(o[3].z * rs * bflo(gq1.w), o[3].w * rs * bfhi(gq1.w));
                bf16_t* dst = CR + orow * DM + DC + h * 128 + ov0;
                *(u32x4*)dst = r0v; *(u32x4*)(dst + 8) = r1v;
            }
        }
        f32x2 off = (f32x2){0.f, 0.f}, tot = (f32x2){0.f, 0.f};
#pragma unroll
        for (int s = 0; s < 8; ++s) { const f32x2 v = segs[s * 64 + kp]; if (s < seg) off = off + v; tot = tot + v; }
        const f32x2 etot = (f32x2){__expf(tot.x), __expf(tot.y)};
        if (seg == 0) *(LAS f32x2*)(dec + 2 * kp) = etot;
        unsigned ke0[4], ke1[4], v0[4], v1[4];
#pragma unroll
        for (int i = 0; i < 8; ++i) {
            const f32x2 b = off + cs[i];
            const float q0 = bflo(R.q[i]), q1 = bfhi(R.q[i]), k0 = bflo(R.k[i]), k1 = bfhi(R.k[i]);
            const float e0 = __expf(b.x), e1 = __expf(b.y);
            const float qs0 = q0 * e0, qs1 = q1 * e1;
            const unsigned pq = cvt_pk_bf16(qs0, qs1);
            const unsigned pk = cvt_pk_bf16(k0 * __builtin_amdgcn_rcpf(e0), k1 * __builtin_amdgcn_rcpf(e1));
            const int t = seg * 8 + i;
            *(LAS unsigned*)(lds + SC_QS + t * SC_LD + kp * 4) = pq;
            *(LAS unsigned*)(lds + SC_KE + t * SC_LD + kp * 4) = pk;
            if (i & 1) { ke0[i >> 1] |= pk << 16; ke1[i >> 1] |= pk & 0xffff0000u; v0[i >> 1] |= R.v[i] << 16; v1[i >> 1] |= R.v[i] & 0xffff0000u; }
            else { ke0[i >> 1] = pk & 0xffffu; ke1[i >> 1] = pk >> 16; v0[i >> 1] = R.v[i] & 0xffffu; v1[i >> 1] = R.v[i] >> 16; }
        }
        *(LAS u32x4*)(lds + SC_KET + (2 * kp) * SC_LDT + seg * 16) = (u32x4){ke0[0], ke0[1], ke0[2], ke0[3]};
        *(LAS u32x4*)(lds + SC_KET + (2 * kp + 1) * SC_LDT + seg * 16) = (u32x4){ke1[0], ke1[1], ke1[2], ke1[3]};
        *(LAS u32x4*)(lds + SC_VT + (2 * kp) * SC_LDT + seg * 16) = (u32x4){v0[0], v0[1], v0[2], v0[3]};
        *(LAS u32x4*)(lds + SC_VT + (2 * kp + 1) * SC_LDT + seg * 16) = (u32x4){v1[0], v1[1], v1[2], v1[3]};
        LBAR();
        if (c + 1 < nchunk) scan_load(R, LF, Qb, Kb, Vb, (size_t)rowbase + (c + 1) * 64 + seg * 8, col);
        {
            const int tb = w & 3;
#pragma unroll
            for (int sbi = 0; sbi < 2; ++sbi) {
                const int sb = (w >> 2) * 2 + sbi;
                f32x4 pacc = (f32x4){0.f, 0.f, 0.f, 0.f};
                if (sb <= tb) {
#pragma unroll
                    for (int kt = 0; kt < 4; ++kt) {
                        const bf16x8 af = *(const LAS bf16x8*)(lds + SC_KE + (16 * sb + l15) * SC_LD + (32 * kt + 8 * quad) * 2);
                        const bf16x8 bf = *(const LAS bf16x8*)(lds + SC_QS + (16 * tb + l15) * SC_LD + (32 * kt + 8 * quad) * 2);
                        pacc = __builtin_amdgcn_mfma_f32_16x16x32_bf16(af, bf, pacc, 0, 0, 0);
                    }
                    const int t = 16 * tb + l15, s = 16 * sb + 4 * quad;
#pragma unroll
                    for (int j = 0; j < 4; ++j) if (s + j > t) pacc[j] = 0.f;
                }
                u32x2 p; p.x = cvt_pk_bf16(pacc[0], pacc[1]); p.y = cvt_pk_bf16(pacc[2], pacc[3]);
                *(LAS u32x2*)(lds + SC_P + (16 * tb + l15) * SC_LDT + (16 * sb + 4 * quad) * 2) = p;
            }
        }
        f32x4 oacc[4];
#pragma unroll
        for (int tb = 0; tb < 4; ++tb) oacc[tb] = (f32x4){0.f, 0.f, 0.f, 0.f};
#pragma unroll
        for (int kt = 0; kt < 4; ++kt) {
            u32x4 ap; ap.x = cvt_pk_bf16(sacc[2 * kt][0], sacc[2 * kt][1]); ap.y = cvt_pk_bf16(sacc[2 * kt][2], sacc[2 * kt][3]);
            ap.z = cvt_pk_bf16(sacc[2 * kt + 1][0], sacc[2 * kt + 1][1]); ap.w = cvt_pk_bf16(sacc[2 * kt + 1][2], sacc[2 * kt + 1][3]);
            const bf16x8 af = __builtin_bit_cast(bf16x8, ap);
#pragma unroll
            for (int tb = 0; tb < 4; ++tb) {
                const u32x2 lo = *(const LAS u32x2*)(lds + SC_QS + (16 * tb + l15) * SC_LD + (32 * kt + 4 * quad) * 2);
                const u32x2 hi = *(const LAS u32x2*)(lds + SC_QS + (16 * tb + l15) * SC_LD + (32 * kt + 16 + 4 * quad) * 2);
                const bf16x8 bf = __builtin_bit_cast(bf16x8, (u32x4){lo.x, lo.y, hi.x, hi.y});
                oacc[tb] = __builtin_amdgcn_mfma_f32_16x16x32_bf16(af, bf, oacc[tb], 0, 0, 0);
            }
        }
        const size_t orow = (size_t)rowbase + c * 64 + ot;
        const u32x4 gq0 = *(const u32x4*)(Gb + orow * DH + h * 128 + ov0), gq1 = *(const u32x4*)(Gb + orow * DH + h * 128 + ov0 + 8);
        LBAR();
        bf16x8 vf[2];
#pragma unroll
        for (int st = 0; st < 2; ++st) vf[st] = *(const LAS bf16x8*)(lds + SC_VT + (16 * w + l15) * SC_LDT + (32 * st + 8 * quad) * 2);
#pragma unroll
        for (int tb = 0; tb < 4; ++tb)
#pragma unroll
            for (int st = 0; st < 2; ++st) {
                const bf16x8 bf = *(const LAS bf16x8*)(lds + SC_P + (16 * tb + l15) * SC_LDT + (32 * st + 8 * quad) * 2);
                oacc[tb] = __builtin_amdgcn_mfma_f32_16x16x32_bf16(vf[st], bf, oacc[tb], 0, 0, 0);
            }
#pragma unroll
        for (int tb = 0; tb < 4; ++tb) *(LAS f32x4*)(ob + (16 * tb + l15) * SC_OLD + 16 * w + 4 * quad) = oacc[tb];
#pragma unroll
        for (int kb = 0; kb < 8; ++kb) {
            const f32x4 d = *(const LAS f32x4*)(dec + 16 * kb + 4 * quad);
#pragma unroll
            for (int st = 0; st < 2; ++st) {
                const bf16x8 af = *(const LAS bf16x8*)(lds + SC_KET + (16 * kb + l15) * SC_LDT + (32 * st + 8 * quad) * 2);
                sacc[kb] = __builtin_amdgcn_mfma_f32_16x16x32_bf16(af, vf[st], sacc[kb], 0, 0, 0);
            }
            sacc[kb] = sacc[kb] * d;
        }
        pend = true; p_orow = orow; p_g0 = gq0; p_g1 = gq1;
    }
    LBAR();
    {
        const size_t orow = p_orow; const u32x4 gq0 = p_g0, gq1 = p_g1;
    {
        f32x4 o[4]; float sq = 0.f;
#pragma unroll
        for (int i = 0; i < 4; ++i) { o[i] = *(const LAS f32x4*)(ob + ot * SC_OLD + ov0 + 4 * i); sq += (o[i].x * o[i].x + o[i].y * o[i].y) + (o[i].z * o[i].z + o[i].w * o[i].w); }
        sq += __shfl_xor(sq, 1); sq += __shfl_xor(sq, 2); sq += __shfl_xor(sq, 4);
        const float rs = __builtin_amdgcn_rsqf(sq * (1.0f / 128.0f) + EPS);
        u32x4 r0v, r1v;
        r0v.x = cvt_pk_bf16(o[0].x * rs * bflo(gq0.x), o[0].y * rs * bfhi(gq0.x)); r0v.y = cvt_pk_bf16(o[0].z * rs * bflo(gq0.y), o[0].w * rs * bfhi(gq0.y));
        r0v.z = cvt_pk_bf16(o[1].x * rs * bflo(gq0.z), o[1].y * rs * bfhi(gq0.z)); r0v.w = cvt_pk_bf16(o[1].z * rs * bflo(gq0.w), o[1].w * rs * bfhi(gq0.w));
        r1v.x = cvt_pk_bf16(o[2].x * rs * bflo(gq1.x), o[2].y * rs * bfhi(gq1.x)); r1v.y = cvt_pk_bf16(o[2].z * rs * bflo(gq1.y), o[2].w * rs * bfhi(gq1.y));
        r1v.z = cvt_pk_bf16(o[3].x * rs * bflo(gq1.z), o[3].y * rs * bfhi(gq1.z)); r1v.w = cvt_pk_bf16(o[3].z * rs * bflo(gq1.w), o[3].w * rs * bfhi(gq1.w));
        bf16_t* dst = CR + orow * DM + DC + h * 128 + ov0;
        *(u32x4*)dst = r0v; *(u32x4*)(dst + 8) = r1v;
    }
    }
    float* so = a.out + (sample ? OHS : OHP) + (size_t)(seq * 4 + h) * 128 * 128;
#pragma unroll
    for (int kb = 0; kb < 8; ++kb)
#pragma unroll
        for (int j = 0; j < 4; ++j) so[(size_t)(16 * kb + 4 * quad + j) * 128 + 16 * w + l15] = sacc[kb][j];
    LBAR();
}

__device__ __forceinline__ void small_resid_gemm(const Args& a, LAS unsigned char* lds, int ph, const int wid0) {
    unsigned char* const wsl = ws_reload();
    int tid = wid0 * 64 + (int)__builtin_amdgcn_mbcnt_hi(~0u, __builtin_amdgcn_mbcnt_lo(~0u, 0u)); asm volatile("" : "+v"(tid));
    const int lane = tid & 63, w = __builtin_amdgcn_readfirstlane(tid >> 6), l15 = lane & 15, quad = lane >> 4;
    const int b = blockIdx.x; if (b >= 256) return;
    const int rb = b >> 4, cb = b & 15;
    const int K = (ph == 5) ? DM : FF, nblk = K / 64;
    const bf16_t* A = (const bf16_t*)(wsl + (ph == 5 ? WS_CR : WS_H)) + (size_t)(MP + 64 * rb + l15) * K + 16 * quad;
    const bf16_t* B = (const bf16_t*)(wsl + (ph == 2 ? WS_W2A : ph == 5 ? WS_WOUT : WS_W2B)) + (size_t)(64 * cb + l15) * K + 16 * quad;
    f32x4 acc[4][4];
#pragma unroll
    for (int rt = 0; rt < 4; ++rt)
#pragma unroll
        for (int ct = 0; ct < 4; ++ct) acc[rt][ct] = (f32x4){0.f, 0.f, 0.f, 0.f};
    for (int blk0 = w; blk0 < nblk; blk0 += 16) {
        bf16x8 af[2][2][4], bf[2][2][4];
#pragma unroll
        for (int q = 0; q < 2; ++q) { const int blk = blk0 + 8 * q; if (blk < nblk) {
#pragma unroll
            for (int h = 0; h < 2; ++h)
#pragma unroll
                for (int t = 0; t < 4; ++t) { af[q][h][t] = *(const bf16x8*)(A + (size_t)(16 * t) * K + blk * 64 + 8 * h); bf[q][h][t] = *(const bf16x8*)(B + (size_t)(16 * t) * K + blk * 64 + 8 * h); } } }
#pragma unroll
        for (int q = 0; q < 2; ++q) { const int blk = blk0 + 8 * q; if (blk < nblk) {
#pragma unroll
            for (int h = 0; h < 2; ++h)
#pragma unroll
                for (int rt = 0; rt < 4; ++rt)
#pragma unroll
                    for (int ct = 0; ct < 4; ++ct) acc[rt][ct] = __builtin_amdgcn_mfma_f32_16x16x32_bf16(bf[q][h][ct], af[q][h][rt], acc[rt][ct], 0, 0, 0); } }
    }
    constexpr int PP = 68;
    LAS float* part = (LAS float*)(lds + (size_t)w * (64 * PP * 4));
#pragma unroll
    for (int rt = 0; rt < 4; ++rt)
#pragma unroll
        for (int ct = 0; ct < 4; ++ct) *(LAS f32x4*)(part + (16 * rt + l15) * PP + 16 * ct + 4 * quad) = acc[rt][ct];
    LBAR();
    const int r = tid >> 3, c8 = (tid & 7) * 8;
    f32x4 o0 = (f32x4){0.f, 0.f, 0.f, 0.f}, o1 = o0;
#pragma unroll
    for (int ww = 0; ww < 8; ++ww) { const LAS float* p = (const LAS float*)(lds + (size_t)ww * (64 * PP * 4)) + r * PP + c8; o0 = o0 + *(const LAS f32x4*)p; o1 = o1 + *(const LAS f32x4*)(p + 4); }
    const size_t grow = (size_t)MP + 64 * rb + r;
    const int col = 64 * cb + c8;
    bf16_t* xa = (bf16_t*)(wsl + WS_XA);
    const float scale = (ph == 5) ? 1.0f : 0.5f;
    f32x4 b0, b1;
    if (ph == 2 && !MK_XABASE) { const float* xs = a.in[I_XS] + (grow - MP) * DM + col; b0 = *(const f32x4*)xs; b1 = *(const f32x4*)(xs + 4); }
    else { const u32x4 rr = *(const u32x4*)(xa + grow * DM + col); b0 = (f32x4){bflo(rr.x), bfhi(rr.x), bflo(rr.y), bfhi(rr.y)}; b1 = (f32x4){bflo(rr.z), bfhi(rr.z), bflo(rr.w), bfhi(rr.w)}; }
    o0 = b0 + o0 * scale; o1 = b1 + o1 * scale;
    u32x4 wv; wv.x = cvt_pk_bf16(o0[0], o0[1]); wv.y = cvt_pk_bf16(o0[2], o0[3]); wv.z = cvt_pk_bf16(o1[0], o1[1]); wv.w = cvt_pk_bf16(o1[2], o1[3]);
    *(u32x4*)(xa + grow * DM + col) = wv;
    float s = ((o0[0] * o0[0] + o0[1] * o0[1]) + (o0[2] * o0[2] + o0[3] * o0[3])) + ((o1[0] * o1[0] + o1[1] * o1[1]) + (o1[2] * o1[2] + o1[3] * o1[3]));
    s += __shfl_xor(s, 1); s += __shfl_xor(s, 2); s += __shfl_xor(s, 4);
    if ((tid & 7) == 0) { float* ss_out = (float*)(wsl + WS_SS) + (size_t)(ph == 2 ? 1 : (ph == 5 ? 2 : 3)) * MTOK * 16; ss_out[grow * 16 + cb] = s; }
    LBAR();
}

#define XB_TMO      128
#define XB_XCNT(j)  (256  + 64 * (j))
#define XB_XSUB(j)  (1280 + 64 * (j))
#define XB_XGEN(j)  (2304 + 64 * (j))
#define XB_TOP      3328
#define XB_TOPGEN   3392
#define XCD_BAR_WORDS 3456
#define XB_SPIN_CAP (1u << 18)

__device__ __forceinline__ unsigned xb_ld(unsigned* p)              { return __hip_atomic_load(p, __ATOMIC_RELAXED, __HIP_MEMORY_SCOPE_AGENT); }
__device__ __forceinline__ unsigned xb_add(unsigned* p, unsigned v) { return __hip_atomic_fetch_add(p, v, __ATOMIC_RELAXED, __HIP_MEMORY_SCOPE_AGENT); }
__device__ __forceinline__ unsigned xb_xcc_id() { return (unsigned)__builtin_amdgcn_s_getreg((3 << 11) | 20) & 0xFu; }
#define XB_SPIN(cond, bar) do { unsigned _sp = 0; while (cond) { __builtin_amdgcn_s_sleep(1); \
    if ((++_sp & 255u) == 0u) { if (xb_ld(&(bar)[XB_TMO])) break; if (_sp > XB_SPIN_CAP) { atomicAdd(&(bar)[XB_TMO], 1u); break; } } } } while (0)

struct XcdBarrier {
    unsigned total;
    unsigned* bar; unsigned x;
    volatile LAS unsigned* st;
};

__device__ __forceinline__ XcdBarrier xcd_barrier_post(unsigned* bar, volatile LAS unsigned* st, bool t0, unsigned total) {
    XcdBarrier b; b.total = total; b.bar = bar; b.x = xb_xcc_id(); b.st = st;
    if (t0) (void)xb_add(&bar[XB_XCNT(b.x)], 1u);
    return b;
}
__device__ __forceinline__ void xcd_barrier_complete(unsigned* bar, unsigned x, unsigned& nloc, unsigned& nx, const unsigned G) {
    unsigned sum, cnt, mine, sp = 0u;
    for (;;) {
        sum = 0u; cnt = 0u; mine = 0u;
#pragma unroll
        for (unsigned j = 0; j < 16; ++j) { const unsigned c = xb_ld(&bar[XB_XCNT(j)]); sum += c; cnt += (c > 0u) ? 1u : 0u; mine = (j == x) ? c : mine; }
        if (sum == G) break;
        __builtin_amdgcn_s_sleep(1);
        if ((++sp & 255u) == 0u) { if (xb_ld(&bar[XB_TMO])) break; if (sp > XB_SPIN_CAP) { atomicAdd(&bar[XB_TMO], 1u); break; } }
    }
    nloc = mine > 0u ? mine : 1u; nx = cnt > 0u ? cnt : 1u;
}

__device__ __forceinline__ void xcd_barrier(const XcdBarrier& b, const int wid0) {
    const bool t0 = (wid0 == 0) && (__builtin_amdgcn_mbcnt_hi(~0u, __builtin_amdgcn_mbcnt_lo(~0u, 0u)) == 0u);
    asm volatile("s_waitcnt vmcnt(0)" ::: "memory");
    __syncthreads();
    if (t0) {
        unsigned* bar = b.bar;
        __builtin_amdgcn_s_waitcnt(0);
        unsigned nloc = b.st[0], nx = b.st[1];
        if (nloc == 0u) { xcd_barrier_complete(bar, b.x, nloc, nx, b.total); b.st[0] = nloc; b.st[1] = nx; }
        const unsigned old = xb_add(&bar[XB_XSUB(b.x)], 1u);
        const unsigned gen = old / nloc;
        if (old + 1u == (gen + 1u) * nloc) {
            __builtin_amdgcn_fence(__ATOMIC_RELEASE, "agent");
            asm volatile("s_waitcnt vmcnt(0)" ::: "memory");
            const unsigned og = xb_add(&bar[XB_TOP], 1u);
            const unsigned tg = og / nx;
            if (og + 1u == (tg + 1u) * nx) xb_add(&bar[XB_TOPGEN], 1u);
            else XB_SPIN(xb_ld(&bar[XB_TOPGEN]) == tg, bar);
            __builtin_amdgcn_fence(__ATOMIC_ACQUIRE, "agent");
            xb_add(&bar[XB_XGEN(b.x)], 1u);
            asm volatile("s_waitcnt vmcnt(0)" ::: "memory");
        } else {
            XB_SPIN(xb_ld(&bar[XB_XGEN(b.x)]) == gen, bar);
            __builtin_amdgcn_fence(__ATOMIC_ACQUIRE, "agent");
            asm volatile("s_waitcnt vmcnt(0)" ::: "memory");
        }
    }
    __syncthreads();
}


__global__ void __launch_bounds__(512, 2) fwd_megakernel(Args a) {
    extern __shared__ __attribute__((aligned(16))) unsigned char lds_raw[];
    LAS unsigned char* lds = (LAS unsigned char*)lds_raw;
    cg::grid_group grid = cg::this_grid();
    const int G = gridDim.x;
    const int wid0 = __builtin_amdgcn_readfirstlane((int)threadIdx.x >> 6);
    volatile LAS unsigned* bst = (volatile LAS unsigned*)(lds + LDS_BYTES - 64);
    if (threadIdx.x < 4) bst[threadIdx.x] = 0u;
    const bool thr0 = threadIdx.x == 0;
    __syncthreads();
    grid.sync();
    XcdBarrier xbar = xcd_barrier_post((unsigned*)(a.ws + WS_BAR), bst, thr0, (unsigned)G);
    XcdBarrier xbar2 = xbar;
    if (blockIdx.x >= 64) xbar2 = xcd_barrier_post((unsigned*)(a.ws + WS_BAR + 16384), bst + 2, thr0, (unsigned)(G - 64));
    for (int pi = a.ph_lo; pi < a.ph_hi; ++pi) {
        unsigned char* ws = ws_reload();
        const int ph = (MK_DUP >= 0 && pi > MK_DUP) ? pi - 1 : pi;
        if (ph == 0) { p0_weights(a, lds, 0, 1408, (int)blockIdx.x * 8 + wid0, G * 8, wid0); p0_rows(a, G, wid0); }
        else if (ph == 4) {
            const int b = blockIdx.x;
            if (b < 64) scan_item(a, lds, false, b >> 2, b & 3, wid0);
            else {
                pg8::Gemm g{(const bf16_t*)(ws + WS_XA), (const bf16_t*)(ws + WS_WIN), MTOK, DM, DM};
                pg8::Epi E{2, 1, 3, 0, 0};
                pg8::StaticOrder S; S.init(g.M, g.N, G - 64, b - 64);
                pg8::gemm_phase(a, lds, g, S, E, wid0);
                pg8::Gemm g2{(const bf16_t*)(ws + WS_XA) + (size_t)MP * DM, (const bf16_t*)(ws + WS_WIN) + (size_t)4 * 256 * DM, MS, DIN - 4 * 256, DM};
                pg8::Epi E2{2, 1, 3, 4, MP / 256};
                pg8::StaticOrder S2; S2.init(g2.M, g2.N, G - 64, b - 64);
                pg8::gemm_phase(a, lds, g2, S2, E2, wid0);
                xcd_barrier(xbar2, wid0);
                if (b < 128) scan_item(a, lds, true, (b - 64) >> 2, b & 3, wid0);
                conv_items(a, lds, b - 64, G - 64, wid0);
            }
        }
        else if (ph == 8) p8_final(a, G, wid0);
        else {
            const bool up = (ph == 1 || ph == 6), down = (ph == 2 || ph == 7);
            const size_t aoff = down ? WS_H : (ph == 5 ? WS_CR : WS_XA);
            const size_t boff = ph == 1 ? WS_W13A : ph == 2 ? WS_W2A : ph == 3 ? WS_WIN : ph == 5 ? WS_WOUT : ph == 6 ? WS_W13B : WS_W2B;
            const bool resid = down || ph == 5;
            pg8::Gemm g{(const bf16_t*)(ws + aoff), (const bf16_t*)(ws + boff + (ph == 3 ? (size_t)4 * 256 * DM * 2 : 0)), (resid || ph == 3) ? MP : MTOK, up ? 2 * FF : (ph == 3 ? DIN - 4 * 256 : DM), down ? FF : DM};
            pg8::Epi E{up ? 0 : (ph == 3 ? 2 : 1), 1, ph, ph == 3 ? 4 : 0, 0};
            pg8::StaticOrder S; S.init(g.M, g.N, G, (int)blockIdx.x);
            pg8::gemm_phase(a, lds, g, S, E, wid0);
            if (ph == 1 && G == 256 && (int)blockIdx.x >= 88) p0_weights(a, lds, 1408, 5248, ((int)blockIdx.x - 88) * 8 + wid0, 168 * 8, wid0);
            if (ph == 1 && G != 256 && blockIdx.x == 0) p0_weights(a, lds, 1408, 5248, wid0, 8, wid0);
            if (resid) small_resid_gemm(a, lds, ph, wid0);
        }
        if (pi + 1 < a.ph_hi) xcd_barrier(xbar, wid0);
    }
}

extern "C" void kernel_launch(void* const* d_in, const int* in_sizes, int n_in, void* d_out, int out_size, void* d_ws, size_t ws_size, hipStream_t stream) {
    static int grid = 0;
    if (grid == 0) {
        if (n_in != 22 || ws_size < WS_END) { fprintf(stderr, "kernel_launch: unexpected n_in %d / ws %zu\n", n_in, ws_size); grid = -1; return; }
        int dev = 0, cus = 0, per_cu = 0;
        hipGetDevice(&dev); hipDeviceGetAttribute(&cus, hipDeviceAttributeMultiprocessorCount, dev);
        if (hipFuncSetAttribute((const void*)fwd_megakernel, hipFuncAttributeMaxDynamicSharedMemorySize, LDS_BYTES) != hipSuccess) { fprintf(stderr, "kernel_launch: hipFuncSetAttribute failed\n"); grid = -1; return; }
        if (hipOccupancyMaxActiveBlocksPerMultiprocessor(&per_cu, (const void*)fwd_megakernel, 512, LDS_BYTES) != hipSuccess || per_cu < 1) { fprintf(stderr, "kernel_launch: occupancy query says %d\n", per_cu); per_cu = 1; }
        (void)hipGetLastError();
        grid = cus * per_cu;
        fprintf(stderr, "kernel_launch: grid %d (cus %d x %d)\n", grid, cus, per_cu);
        if (grid < 256) { fprintf(stderr, "kernel_launch: this kernel needs at least 256 co-resident workgroups (64x64 sample tiles, scan items); nothing launched\n"); grid = -1; return; }
    }
    if (grid < 0) return;
    Args a{};
    for (int i = 0; i < 22; ++i) a.in[i] = (const float*)d_in[i];
    a.out = (float*)d_out; a.ws = (unsigned char*)d_ws;
    if (hipMemsetAsync((char*)d_ws + WS_BAR, 0, 32768, stream) != hipSuccess) { fprintf(stderr, "kernel_launch: memset of the barrier words failed\n"); return; }
    a.ph_lo = 0; a.ph_hi = 9 + (MK_DUP >= 0 ? 1 : 0);
    void* args[] = {&a};
    hipError_t e = hipLaunchCooperativeKernel((const void*)fwd_megakernel, dim3(grid), dim3(512), args, LDS_BYTES, stream);
    if (e != hipSuccess) fprintf(stderr, "cooperative launch failed: %s (grid %d)\n", hipGetErrorString(e), grid);
}
```

```cpp
#include <hip/hip_runtime.h>
#include <hip/hip_cooperative_groups.h>
#include <cstdio>
#include <cstdint>
namespace cg = cooperative_groups;
#ifndef MK_XABASE
#define MK_XABASE 1
#endif
#ifndef MK_DUP
#define MK_DUP -1
#endif

#define LAS __attribute__((address_space(3)))
typedef unsigned short bf16_t;
typedef short bf16x8 __attribute__((ext_vector_type(8)));
typedef float f32x4 __attribute__((ext_vector_type(4)));
typedef unsigned u32x4 __attribute__((ext_vector_type(4)));
typedef unsigned u32x2 __attribute__((ext_vector_type(2)));

__device__ __forceinline__ unsigned cvt_pk_bf16(float lo, float hi) { unsigned r; asm volatile("v_cvt_pk_bf16_f32 %0, %1, %2" : "=v"(r) : "v"(lo), "v"(hi)); return r; }
__device__ __forceinline__ float bf2f(unsigned h) { return __uint_as_float(h << 16); }
__device__ __forceinline__ float bflo(unsigned w) { return __uint_as_float(w << 16); }
__device__ __forceinline__ float bfhi(unsigned w) { return __uint_as_float(w & 0xffff0000u); }
__device__ __forceinline__ float sigmoidf_(float x) { return __builtin_amdgcn_rcpf(1.0f + __expf(-x)); }
__device__ __forceinline__ float siluf_(float x) { return x * sigmoidf_(x); }
__device__ __forceinline__ float ss_row(const float* ssb, size_t row, int q, int stride) {
    const f32x4 v = *(const f32x4*)(ssb + row * 16 + 4 * q);
    float s = (v.x + v.y) + (v.z + v.w);
    s += __shfl_xor(s, stride); s += __shfl_xor(s, 2 * stride);
    return s;
}
__device__ __forceinline__ void rs_rows(const float* ssb, int row0, int fq, float (&rs)[8]) {
    f32x4 v[8];
#pragma unroll
    for (int i = 0; i < 8; ++i) v[i] = *(const f32x4*)(ssb + (size_t)(row0 + (i >> 2) * 128 + (i & 3) * 16) * 16 + 4 * fq);
#pragma unroll
    for (int i = 0; i < 8; ++i) { float s = (v[i].x + v[i].y) + (v[i].z + v[i].w); s += __shfl_xor(s, 16); s += __shfl_xor(s, 32); rs[i] = __builtin_amdgcn_rsqf(s * (1.0f / 1024.0f) + 1e-6f); }
}
#define LBAR() do { asm volatile("s_waitcnt lgkmcnt(0)" ::: "memory"); __builtin_amdgcn_s_barrier(); asm volatile("" ::: "memory"); } while (0)

constexpr int MP = 32768, MS = 1024, MTOK = MP + MS, DM = 1024, FF = 2816, DIN = 3072, DC = 512, DH = 512;
constexpr int TP = 2048, TS = 64, NB = 16, CW = 31;
constexpr float EPS = 1e-6f;
constexpr size_t MiB = 1u << 20;
constexpr size_t WS_SS = 424 * MiB;
constexpr size_t WS_W13A = 2 * MiB, WS_W2A = 13 * MiB, WS_WIN = 19 * MiB, WS_WOUT = 25 * MiB, WS_W13B = 27 * MiB, WS_W2B = 38 * MiB;
constexpr size_t WS_XA = 44 * MiB, WS_H = 110 * MiB;
constexpr size_t WS_U = 110 * MiB, WS_Q = 143 * MiB, WS_K = 176 * MiB, WS_V = 209 * MiB, WS_G = 242 * MiB, WS_LF = 292 * MiB, WS_CR = 358 * MiB, WS_BAR = 434 * MiB, WS_END = 435 * MiB;
constexpr size_t OY = 0, OCP = (size_t)MTOK * DM, OHP = OCP + 16 * 30 * 512, OCS = OHP + 16 * 4 * 128 * 128, OHS = OCS + 16 * 30 * 512;
constexpr int LDS_BYTES = 147456;

struct Args { const float* in[22]; float* out; unsigned char* ws; int ph_lo, ph_hi; };
enum { I_XP = 0, I_XS, I_SCONV, I_SHGRN, I_N1, I_F1W1, I_F1W3, I_F1W2, I_NM, I_WIN, I_DWW, I_DWB, I_LNG, I_LNB, I_LOGITS, I_GN, I_WOUT, I_N2, I_F2W1, I_F2W3, I_F2W2, I_NF };

__device__ __forceinline__ unsigned char* ws_reload() {
    typedef unsigned char* ptr_t;
    const __attribute__((address_space(4))) char* ka = (const __attribute__((address_space(4))) char*)__builtin_amdgcn_kernarg_segment_ptr();
    return *(const volatile __attribute__((address_space(4))) ptr_t*)(ka + 22 * 8 + 8);
}

namespace pg8 {
constexpr int BM = 256, BK = 64, HALF = 128, HTB = HALF * BK * 2  , STAGE_BYTES = 8 * HTB, NXCD = 8, WGM = 8;
__host__ __device__ __forceinline__ int lds_byte(int r, int c) { const int st = (r >> 4) * 2 + (c >> 5), rr = r & 15, cc = c & 31, ob = rr * 64 + cc * 2; return st * 1024 + (ob ^ (((ob >> 9) & 1) << 5)); }
__host__ __device__ __forceinline__ void stage_rc(int b, int& R, int& C) { const int st = b / 1024, sb = b % 1024, swz = sb ^ (((sb >> 9) & 1) << 5); R = (st >> 1) * 16 + swz / 64; C = (st & 1) * 32 + (swz % 64) / 2; }
__host__ __device__ __forceinline__ int perm32(int rho) { const int n = rho >> 4, i = rho & 15; return 8 * (i >> 2) + 4 * n + (i & 3); }

struct Unit { int pm, pn; };
struct Gemm { const bf16_t* A; const bf16_t* Bt; int M, N, K; };

struct StaticOrder {
    int nM, nN, nwg, G, c;
    __host__ __device__ void init(int M, int N, int G_, int c_) { nM = M / BM; nN = N / BM; nwg = nM * nN; G = G_; c = c_; }
    __host__ __device__ bool next(int i, Unit& u) const {
        const long L = (long)i * G + c; if (L >= nwg) return false;
        int wgid = (int)L; { const int q = nwg / NXCD, r = nwg % NXCD, xcd = wgid % NXCD, off = wgid / NXCD; wgid = (xcd < r ? xcd * (q + 1) : r * (q + 1) + (xcd - r) * q) + off; }
        const int nig = WGM * nN, gid = wgid / nig, fm = gid * WGM, gsz = (nM - fm) < WGM ? (nM - fm) : WGM;
        u.pm = fm + ((wgid % nig) % gsz); u.pn = (wgid % nig) / gsz; return true;
    }
};

struct Epi { int kind, perm, ph, pn_off, pm_off; };

__device__ __forceinline__ void epi_swiglu(const Args& a, const Epi& E, const f32x4 (&acc)[2][2][4][2], const Unit& u, int wr, int wc, int fr, int fq, const LAS float* rst) {
    unsigned char* const wsl = ws_reload();
    asm volatile("" : "+v"(fr), "+v"(fq));
    const int row0 = u.pm * BM + wr * 64 + fr, col0 = u.pn * HALF + wc * 32 + 8 * fq;
    const float* ss_in = (const float*)(wsl + WS_SS) + (E.ph == 1 ? 0 : 2 * (size_t)MTOK * 16);
    bf16_t* Hh = (bf16_t*)(wsl + WS_H);
    float rs8[8];
#pragma unroll
    for (int i = 0; i < 8; ++i) rs8[i] = rst[(i >> 2) * HALF + wr * 64 + (i & 3) * 16 + fr];
#pragma unroll
    for (int ai = 0; ai < 2; ++ai)
#pragma unroll
        for (int m = 0; m < 4; ++m) {
            const int row = row0 + ai * HALF + m * 16;
            const float rs = rs8[ai * 4 + m];
            float h[8];
#pragma unroll
            for (int n = 0; n < 2; ++n)
#pragma unroll
                for (int j = 0; j < 4; ++j) { const float av = acc[ai][0][m][n][j] * rs, b = acc[ai][1][m][n][j] * rs; h[n * 4 + j] = siluf_(av) * b; }
            u32x4 w; w.x = cvt_pk_bf16(h[0], h[1]); w.y = cvt_pk_bf16(h[2], h[3]); w.z = cvt_pk_bf16(h[4], h[5]); w.w = cvt_pk_bf16(h[6], h[7]);
            *(u32x4*)(Hh + (size_t)row * FF + col0) = w;
        }
}

__device__ __forceinline__ void epi_resid(const Args& a, const Epi& E, const f32x4 (&acc)[2][2][4][2], const Unit& u, int wr, int wc, int fr, int fq) {
    unsigned char* const wsl = ws_reload();
    asm volatile("" : "+v"(fr), "+v"(fq));
    bf16_t* xa = (bf16_t*)(wsl + WS_XA);
    const float* xin = (u.pm < MP / BM) ? a.in[I_XP] + (size_t)u.pm * BM * DM : a.in[I_XS] + (size_t)(u.pm - MP / BM) * BM * DM;
    const float scale = (E.ph == 5) ? 1.0f : 0.5f;
    float* ss_out = (float*)(wsl + WS_SS) + (size_t)(E.ph == 2 ? 1 : (E.ph == 5 ? 2 : 3)) * MTOK * 16;
    const int col0 = u.pn * BM + wc * 32 + 8 * fq;
#pragma unroll
    for (int ai = 0; ai < 2; ++ai) {
        f32x4 bb[4][2][2];
        if (E.ph == 2 && !MK_XABASE) {
#pragma unroll
            for (int m = 0; m < 4; ++m)
#pragma unroll
                for (int bj = 0; bj < 2; ++bj)
#pragma unroll
                    for (int n = 0; n < 2; ++n) bb[m][bj][n] = *(const f32x4*)(xin + (size_t)(ai * HALF + wr * 64 + m * 16 + fr) * DM + col0 + bj * HALF + n * 4);
        } else {
            u32x4 rb[4][2];
#pragma unroll
            for (int m = 0; m < 4; ++m)
#pragma unroll
                for (int bj = 0; bj < 2; ++bj) rb[m][bj] = *(const u32x4*)(xa + ((size_t)u.pm * BM + ai * HALF + wr * 64 + m * 16 + fr) * DM + col0 + bj * HALF);
#pragma unroll
            for (int m = 0; m < 4; ++m)
#pragma unroll
                for (int bj = 0; bj < 2; ++bj) { const u32x4 r = rb[m][bj]; bb[m][bj][0] = (f32x4){bflo(r.x), bfhi(r.x), bflo(r.y), bfhi(r.y)}; bb[m][bj][1] = (f32x4){bflo(r.z), bfhi(r.z), bflo(r.w), bfhi(r.w)}; }
        }
#pragma unroll
        for (int m = 0; m < 4; ++m) {
            const int lr = ai * HALF + wr * 64 + m * 16 + fr; const size_t grow = (size_t)u.pm * BM + lr;
            float s = 0.f;
#pragma unroll
            for (int bj = 0; bj < 2; ++bj) {
                const f32x4 o0 = bb[m][bj][0] + acc[ai][bj][m][0] * scale, o1 = bb[m][bj][1] + acc[ai][bj][m][1] * scale;
                u32x4 w; w.x = cvt_pk_bf16(o0[0], o0[1]); w.y = cvt_pk_bf16(o0[2], o0[3]); w.z = cvt_pk_bf16(o1[0], o1[1]); w.w = cvt_pk_bf16(o1[2], o1[3]);
                *(u32x4*)(xa + grow * DM + col0 + bj * HALF) = w;
                s += ((o0[0] * o0[0] + o0[1] * o0[1]) + (o0[2] * o0[2] + o0[3] * o0[3])) + ((o1[0] * o1[0] + o1[1] * o1[1]) + (o1[2] * o1[2] + o1[3] * o1[3]));
            }
            s += __shfl_xor(s, 16); s += __shfl_xor(s, 32);
            if (fq == 0) ss_out[grow * 16 + u.pn * 4 + wc] = s;
        }
        asm volatile("" ::: "memory");
    }
}

__device__ __forceinline__ void epi_mix(const Args& a, const Epi& E, const f32x4 (&acc)[2][2][4][2], const Unit& u, int wr, int wc, int fr, int fq, const LAS float* rst) {
    unsigned char* const wsl = ws_reload();
    asm volatile("" : "+v"(fr), "+v"(fq));
    const int pmg = u.pm + E.pm_off;
    const int row0 = pmg * BM + wr * 64 + fr;
    const float* ss_in = (const float*)(wsl + WS_SS) + (size_t)MTOK * 16;
    float rs8[8];
#pragma unroll
    for (int i = 0; i < 8; ++i) rs8[i] = rst[(i >> 2) * HALF + wr * 64 + (i & 3) * 16 + fr];
    const int pn = u.pn + E.pn_off;
    if (pn < 4) {
        const int ch0 = pn * HALF + wc * 32 + 8 * fq;
#pragma unroll
        for (int ai = 0; ai < 2; ++ai)
#pragma unroll
            for (int m = 0; m < 4; ++m) {
                const int row = row0 + ai * HALF + m * 16;
                const float rs = rs8[ai * 4 + m];
                float h[8];
#pragma unroll
                for (int n = 0; n < 2; ++n)
#pragma unroll
                    for (int j = 0; j < 4; ++j) { const float a = acc[ai][0][m][n][j] * rs, g = acc[ai][1][m][n][j] * rs; h[n * 4 + j] = a * sigmoidf_(g); }
                u32x4 w; w.x = cvt_pk_bf16(h[0], h[1]); w.y = cvt_pk_bf16(h[2], h[3]); w.z = cvt_pk_bf16(h[4], h[5]); w.w = cvt_pk_bf16(h[6], h[7]);
                *(u32x4*)((bf16_t*)(wsl + WS_U) + (size_t)row * DC + ch0) = w;
                const bool samp = pmg >= MP / BM;
                const int r2 = samp ? row - MP : row, sh = samp ? 6 : 11, T = samp ? TS : TP, seq = r2 >> sh, t = r2 & (T - 1);
                const size_t obase = samp ? OCS : OCP;
                if (t >= T - 30) { float* d = a.out + obase + ((size_t)(seq * 30 + (t - (T - 30))) * DC + ch0);
                    *(f32x4*)d = (f32x4){h[0], h[1], h[2], h[3]}; *(f32x4*)(d + 4) = (f32x4){h[4], h[5], h[6], h[7]}; }
                asm volatile("" ::: "memory");
            }
    } else {
        const int typ = (pn - 4) >> 1;
        const size_t dsto = typ == 0 ? WS_Q : typ == 1 ? WS_K : typ == 2 ? WS_V : WS_G;
        bf16_t* dstb = (bf16_t*)(wsl + dsto);
#pragma unroll
        for (int bj = 0; bj < 2; ++bj) {
            const int cc0 = ((pn - 4) & 1) * BM + bj * HALF + wc * 32 + 8 * fq;
            f32x4 aux[2] = {(f32x4){0.f, 0.f, 0.f, 0.f}, (f32x4){0.f, 0.f, 0.f, 0.f}};
            if (typ == 1) {
#pragma unroll
                for (int n = 0; n < 2; ++n) { const f32x4 l0 = *(const f32x4*)(a.in[I_LOGITS] + cc0 + 4 * n), l1 = *(const f32x4*)(a.in[I_LOGITS] + DH + cc0 + 4 * n);
#pragma unroll
                    for (int j = 0; j < 4; ++j) aux[n][j] = sigmoidf_(l0[j] - l1[j]); }
            } else if (typ == 3) { aux[0] = *(const f32x4*)(a.in[I_GN] + cc0); aux[1] = *(const f32x4*)(a.in[I_GN] + cc0 + 4); }
#pragma unroll
            for (int ai = 0; ai < 2; ++ai)
#pragma unroll
                for (int m = 0; m < 4; ++m) {
                    const int row = row0 + ai * HALF + m * 16;
                    const float rs = rs8[ai * 4 + m];
                    u32x4 w;
#pragma unroll
                    for (int n = 0; n < 2; ++n) {
                        const f32x4 v = acc[ai][bj][m][n] * rs;
                        f32x4 h;
                        if (typ == 0) {
#pragma unroll
                            for (int j = 0; j < 4; ++j) h[j] = siluf_(v[j]);
                        } else if (typ == 1) { f32x4 lf;
#pragma unroll
                            for (int j = 0; j < 4; ++j) { const float sg = sigmoidf_(v[j]); lf[j] = __logf(aux[n][j] + (1.0f - aux[n][j]) * sg); h[j] = (1.0f - aux[n][j]) * (1.0f - sg); }
                            *(f32x4*)((float*)(wsl + WS_LF) + (size_t)row * DH + cc0 + 4 * n) = lf;
                        } else if (typ == 2) h = v;
                        else {
#pragma unroll
                            for (int j = 0; j < 4; ++j) h[j] = aux[n][j] * siluf_(v[j]);
                        }
                        if (n == 0) { w.x = cvt_pk_bf16(h[0], h[1]); w.y = cvt_pk_bf16(h[2], h[3]); } else { w.z = cvt_pk_bf16(h[0], h[1]); w.w = cvt_pk_bf16(h[2], h[3]); }
                    }
                    *(u32x4*)(dstb + (size_t)row * DH + cc0) = w;
                    asm volatile("" ::: "memory");
                }
        }
    }
}

__device__ __forceinline__ void gemm_phase(const Args& a, LAS unsigned char* lds, const Gemm g, const StaticOrder& S, const Epi& E, const int wid0) {
    int tid = wid0 * 64 + (int)__builtin_amdgcn_mbcnt_hi(~0u, __builtin_amdgcn_mbcnt_lo(~0u, 0u)); asm volatile("" : "+v"(tid));
    const int wid = __builtin_amdgcn_readfirstlane(tid >> 6), lane = tid & 63, wr = wid >> 2, wc = wid & 3, fr = lane & 15, fq = lane >> 4;
    const int K = g.K, nt = K / BK;
    unsigned voffA[2], voffB[2];
#pragma unroll
    for (int i = 0; i < 2; ++i) { int R, C; stage_rc(tid * 16 + i * 8192, R, C); const int Rb = E.perm ? ((R & ~31) + perm32(R & 31)) : R;
        voffA[i] = (unsigned)(R * K + C) * 2u; voffB[i] = (unsigned)(Rb * K + C) * 2u; }
    const size_t kstep = (size_t)(BK * 2);
    const size_t hstep = (size_t)HALF * K * 2;
    const size_t tstep = 2 * hstep;
    const unsigned ldsw = (unsigned)wid * 1024u;
    const int aoff = lds_byte(wr * 64 + fr, fq * 8), boff = lds_byte(wc * 32 + fr, fq * 8);
#define PG8_SA(b, h) (((b) * 2 + (h)) * HTB)
#define PG8_SB(b, h) ((4 + (b) * 2 + (h)) * HTB)
#define PG8_STAGE(bufoff, gbase, voff) do { _Pragma("unroll") for (int _i = 0; _i < 2; ++_i) \
        __builtin_amdgcn_global_load_lds((const unsigned*)((const char*)(gbase) + (voff)[_i]), (LAS unsigned*)(lds + (bufoff) + ldsw + _i * 8192), 16, 0, 0); } while (0)
#define PG8_LDA(dst, b, h) do { _Pragma("unroll") for (int m = 0; m < 4; ++m) _Pragma("unroll") for (int k = 0; k < 2; ++k) dst[m][k] = *(const LAS bf16x8*)(lds + PG8_SA(b, h) + aoff + m * 2048 + k * 1024); } while (0)
#define PG8_LDB(dst, b, h) do { _Pragma("unroll") for (int n = 0; n < 2; ++n) _Pragma("unroll") for (int k = 0; k < 2; ++k) dst[n][k] = *(const LAS bf16x8*)(lds + PG8_SB(b, h) + boff + n * 2048 + k * 1024); } while (0)
#define PG8_MMA(ai, bj, At, Bt) do { __builtin_amdgcn_s_setprio(1); _Pragma("unroll") for (int m = 0; m < 4; ++m) _Pragma("unroll") for (int n = 0; n < 2; ++n) _Pragma("unroll") for (int k = 0; k < 2; ++k) \
        acc[ai][bj][m][n] = __builtin_amdgcn_mfma_f32_16x16x32_bf16(Bt[n][k], At[m][k], acc[ai][bj][m][n], 0, 0, 0); __builtin_amdgcn_s_setprio(0); } while (0)
#define PG8_WAIT_V(n) asm volatile("s_waitcnt vmcnt(" #n ")" ::: "memory")
#define PG8_WAIT_L(n) asm volatile("s_waitcnt lgkmcnt(" #n ")" ::: "memory")
#define PG8_BAR __builtin_amdgcn_s_barrier()
#define PG8_SCHED __builtin_amdgcn_sched_barrier(0)
    Unit cur, nxt; int ui = 0;
    if (!S.next(0, cur)) return;
    LAS float* rstab = (LAS float*)(lds + STAGE_BYTES);
    if (E.kind != 1) {
        const float* ssb = (const float*)(ws_reload() + WS_SS) + (E.kind == 2 ? (size_t)MTOK * 16 : (E.ph == 1 ? 0 : 2 * (size_t)MTOK * 16));
        for (int j = tid; ; j += 512) { Unit uu; if (!S.next(j >> 8, uu)) break;
            const f32x4* p = (const f32x4*)(ssb + ((size_t)(uu.pm + (E.kind == 2 ? E.pm_off : 0)) * BM + (j & 255)) * 16); const f32x4 x0 = p[0], x1 = p[1], x2 = p[2], x3 = p[3];
            const float s = (((x0.x + x0.y) + (x0.z + x0.w)) + ((x1.x + x1.y) + (x1.z + x1.w))) + (((x2.x + x2.y) + (x2.z + x2.w)) + ((x3.x + x3.y) + (x3.z + x3.w)));
            rstab[j] = __builtin_amdgcn_rsqf(s * (1.0f / 1024.0f) + 1e-6f); }
        asm volatile("s_waitcnt vmcnt(0) lgkmcnt(0)" ::: "memory"); __builtin_amdgcn_s_barrier(); asm volatile("" ::: "memory");
    }
    f32x4 acc[2][2][4][2];
#pragma unroll
    for (int a = 0; a < 2; ++a)
#pragma unroll
        for (int b = 0; b < 2; ++b)
#pragma unroll
            for (int m = 0; m < 4; ++m)
#pragma unroll
                for (int n = 0; n < 2; ++n) acc[a][b][m][n] = (f32x4){0.f, 0.f, 0.f, 0.f};
    bf16x8 At[4][2], B0[2][2], B1[2][2];
    const char* cA = (const char*)g.A + (size_t)cur.pm * tstep; const char* cB = (const char*)g.Bt + (size_t)cur.pn * tstep;
    PG8_STAGE(PG8_SB(0, 0), cB, voffB); PG8_STAGE(PG8_SB(0, 1), cB + hstep, voffB); PG8_STAGE(PG8_SA(0, 0), cA, voffA); PG8_STAGE(PG8_SA(0, 1), cA + hstep, voffA);
    if (wr == 1) PG8_BAR;
    PG8_WAIT_V(2); PG8_BAR;
    PG8_STAGE(PG8_SB(1, 0), cB + kstep, voffB); PG8_STAGE(PG8_SA(1, 0), cA + kstep, voffA); PG8_STAGE(PG8_SB(1, 1), cB + hstep + kstep, voffB);
    PG8_WAIT_V(6); PG8_BAR;
    for (;;) {
        const bool has_next = S.next(ui + 1, nxt);
        const char* nA = has_next ? (const char*)g.A + (size_t)nxt.pm * tstep : cA; const char* nB = has_next ? (const char*)g.Bt + (size_t)nxt.pn * tstep : cB;
        for (int t = 0; t < nt; t += 2) {
            const bool last = (t == nt - 2);
            const char* a1 = cA + (size_t)(t + 1) * kstep;
            const char* a2 = last ? nA : cA + (size_t)(t + 2) * kstep; const char* b2 = last ? nB : cB + (size_t)(t + 2) * kstep;
            const char* a3 = a2 + kstep; const char* b3 = b2 + kstep;
            PG8_LDB(B0, 0, 0); PG8_LDB(B1, 0, 1); PG8_SCHED; PG8_LDA(At, 0, 0); PG8_STAGE(PG8_SA(1, 1), a1 + hstep, voffA);
            PG8_WAIT_V(8); PG8_WAIT_L(0); PG8_BAR; PG8_MMA(0, 0, At, B0); PG8_MMA(0, 1, At, B1); PG8_BAR; PG8_SCHED;
            PG8_LDA(At, 0, 1); PG8_STAGE(PG8_SB(0, 0), b2, voffB); PG8_STAGE(PG8_SB(0, 1), b2 + hstep, voffB); PG8_STAGE(PG8_SA(0, 0), a2, voffA);
            PG8_WAIT_V(8); PG8_WAIT_L(0); PG8_BAR; PG8_MMA(1, 0, At, B0); PG8_MMA(1, 1, At, B1); PG8_BAR; PG8_SCHED;
            PG8_LDB(B0, 1, 0); PG8_LDB(B1, 1, 1); PG8_SCHED; PG8_LDA(At, 1, 0); PG8_STAGE(PG8_SA(0, 1), a2 + hstep, voffA);
            PG8_WAIT_V(8); PG8_WAIT_L(0); PG8_BAR; PG8_MMA(0, 0, At, B0); PG8_MMA(0, 1, At, B1); PG8_BAR; PG8_SCHED;
            PG8_LDA(At, 1, 1); PG8_STAGE(PG8_SB(1, 0), b3, voffB); PG8_STAGE(PG8_SB(1, 1), b3 + hstep, voffB); PG8_STAGE(PG8_SA(1, 0), a3, voffA);
            PG8_WAIT_V(8); PG8_WAIT_L(0); PG8_BAR; PG8_MMA(1, 0, At, B0); PG8_MMA(1, 1, At, B1); PG8_BAR; PG8_SCHED;
        }
        if (wr == 0) PG8_BAR;
        if (E.kind == 0) epi_swiglu(a, E, acc, cur, wr, wc, fr, fq, rstab + ui * 256);
        else if (E.kind == 1) epi_resid(a, E, acc, cur, wr, wc, fr, fq);
        else epi_mix(a, E, acc, cur, wr, wc, fr, fq, rstab + ui * 256);
        if (!has_next) break;
#pragma unroll
        for (int a = 0; a < 2; ++a)
#pragma unroll
            for (int b = 0; b < 2; ++b)
#pragma unroll
                for (int m = 0; m < 4; ++m)
#pragma unroll
                    for (int n = 0; n < 2; ++n) acc[a][b][m][n] = (f32x4){0.f, 0.f, 0.f, 0.f};
        cur = nxt; cA = nA; cB = nB; ++ui;
        if (wr == 1) PG8_BAR;
    }
    PG8_WAIT_V(0);
    PG8_BAR;
#undef PG8_SA
#undef PG8_SB
#undef PG8_STAGE
#undef PG8_LDA
#undef PG8_LDB
#undef PG8_MMA
#undef PG8_WAIT_V
#undef PG8_WAIT_L
#undef PG8_BAR
#undef PG8_SCHED
}
}


__device__ __forceinline__ float wave_sum(float v) {
#pragma unroll
    for (int o = 1; o < 64; o <<= 1) v += __shfl_xor(v, o);
    return v;
}

__device__ __forceinline__ void p0_transpose_item(const float* W, int K, int Nsrc, int src_col0, const float* gs, bf16_t* WT, int dst_row0, LAS float* scr, int kb, int lane) {
    const int k0 = 64 * kb, r = lane >> 4, c4 = lane & 15;
    f32x4 v[16];
#pragma unroll
    for (int i = 0; i < 16; ++i) v[i] = __builtin_nontemporal_load((const f32x4*)(W + (size_t)(k0 + 4 * i + r) * Nsrc + src_col0 + 4 * c4));
#pragma unroll
    for (int i = 0; i < 16; ++i) { const float g = gs ? gs[k0 + 4 * i + r] : 1.0f; LAS float* p = scr + (4 * i + r) * 65 + 4 * c4; p[0] = v[i].x * g; p[1] = v[i].y * g; p[2] = v[i].z * g; p[3] = v[i].w * g; }
    asm volatile("s_waitcnt lgkmcnt(0)" ::: "memory");
    const int c = lane & 7;
#pragma unroll
    for (int j = 0; j < 8; ++j) { const int n = (lane >> 3) + 8 * j; const LAS float* s = scr + (8 * c) * 65 + n;
        u32x4 o; o.x = cvt_pk_bf16(s[0 * 65], s[1 * 65]); o.y = cvt_pk_bf16(s[2 * 65], s[3 * 65]); o.z = cvt_pk_bf16(s[4 * 65], s[5 * 65]); o.w = cvt_pk_bf16(s[6 * 65], s[7 * 65]);
        *(u32x4*)(WT + (size_t)(dst_row0 + n) * K + k0 + 8 * c) = o; }
    asm volatile("s_waitcnt lgkmcnt(0)" ::: "memory");
}

__device__ __forceinline__ void p0_weights(const Args& a, LAS unsigned char* lds, int it_lo, int it_hi, int gw, int NGW, const int wid0) {
    unsigned char* const wsl = ws_reload();
    int tid = wid0 * 64 + (int)__builtin_amdgcn_mbcnt_hi(~0u, __builtin_amdgcn_mbcnt_lo(~0u, 0u)); asm volatile("" : "+v"(tid));
    const int lane = tid & 63, wave = tid >> 6;
    LAS float* scr = (LAS float*)(lds + wave * 16896);
    unsigned char* ws = wsl;
    constexpr int N13 = 2 * FF / 64, K13 = DM / 64, I13 = N13 * K13;
    constexpr int N2 = DM / 64, K2 = FF / 64, I2 = N2 * K2;
    constexpr int NIN = DIN / 64, KIN = DM / 64, IIN = NIN * KIN;
    constexpr int NO = DM / 64, KO = DM / 64, IO = NO * KO;
    constexpr int NITEMS = 2 * I13 + 2 * I2 + IIN + IO;
    static_assert(NITEMS == 5248 && I13 == 1408, "item map");
    for (int it = it_lo + gw; it < it_hi; it += NGW) {
        int r = it;
        if (r < 2 * I13) { const int which = r / I13; r -= which * I13; const int nb = r / K13, kb = r % K13, n0 = nb * 64, p = n0 >> 8, within = n0 & 255;
            const float* W = (within < 128) ? a.in[which ? I_F2W1 : I_F1W1] : a.in[which ? I_F2W3 : I_F1W3];
            p0_transpose_item(W, DM, FF, 128 * p + (within & 127), a.in[which ? I_N2 : I_N1], (bf16_t*)(ws + (which ? WS_W13B : WS_W13A)), n0, scr, kb, lane); continue; }
        r -= 2 * I13;
        if (r < 2 * I2) { const int which = r / I2; r -= which * I2; const int nb = r / K2, kb = r % K2;
            p0_transpose_item(a.in[which ? I_F2W2 : I_F1W2], FF, DM, nb * 64, nullptr, (bf16_t*)(ws + (which ? WS_W2B : WS_W2A)), nb * 64, scr, kb, lane); continue; }
        r -= 2 * I2;
        if (r < IIN) { const int nb = r / KIN, kb = r % KIN, n0 = nb * 64; int srcc;
            if (n0 < 1024) { const int p = n0 >> 8, within = n0 & 255; srcc = (within < 128) ? 128 * p + within : 512 + 128 * p + (within - 128); } else srcc = n0;
            p0_transpose_item(a.in[I_WIN], DM, DIN, srcc, a.in[I_NM], (bf16_t*)(ws + WS_WIN), n0, scr, kb, lane); continue; }
        r -= IIN;
        { const int nb = r / KO, kb = r % KO; p0_transpose_item(a.in[I_WOUT], DM, DM, nb * 64, nullptr, (bf16_t*)(ws + WS_WOUT), nb * 64, scr, kb, lane); }
    }
}
__device__ __forceinline__ void p0_rows(const Args& a, int G, const int wid0) {
    unsigned char* const wsl = ws_reload();
    int tid = wid0 * 64 + (int)__builtin_amdgcn_mbcnt_hi(~0u, __builtin_amdgcn_mbcnt_lo(~0u, 0u)); asm volatile("" : "+v"(tid));
    const int lane = tid & 63, wave = tid >> 6;
    const int gw = blockIdx.x * 8 + wave, NGW = G * 8;
    unsigned char* ws = wsl;
    float* ss = (float*)(ws + WS_SS); bf16_t* XA = (bf16_t*)(ws + WS_XA);
    for (int m0 = gw; m0 < MTOK; m0 += 4 * NGW) {
        f32x4 v[4][4];
#pragma unroll
        for (int q = 0; q < 4; ++q) { const int m = m0 + q * NGW; if (m < MTOK) { const float* xr = (m < MP) ? a.in[I_XP] + (size_t)m * DM : a.in[I_XS] + (size_t)(m - MP) * DM;
#pragma unroll
            for (int j = 0; j < 4; ++j) v[q][j] = __builtin_nontemporal_load((const f32x4*)xr + lane + 64 * j); } }
#pragma unroll
        for (int q = 0; q < 4; ++q) { const int m = m0 + q * NGW; if (m < MTOK) {
            float s = 0.f;
#pragma unroll
            for (int j = 0; j < 4; ++j) s += (v[q][j].x * v[q][j].x + v[q][j].y * v[q][j].y) + (v[q][j].z * v[q][j].z + v[q][j].w * v[q][j].w);
            s = wave_sum(s);
            u32x2* o = (u32x2*)(XA + (size_t)m * DM);
#pragma unroll
            for (int j = 0; j < 4; ++j) { u32x2 w; w.x = cvt_pk_bf16(v[q][j].x, v[q][j].y); w.y = cvt_pk_bf16(v[q][j].z, v[q][j].w); o[lane + 64 * j] = w; }
            if (lane < 16) ss[(size_t)m * 16 + lane] = (lane == 0) ? s : 0.f; } }
    }
}

__device__ __forceinline__ void p8_final(const Args& a, int G, const int wid0) {
    unsigned char* const wsl = ws_reload();
    int tid = wid0 * 64 + (int)__builtin_amdgcn_mbcnt_hi(~0u, __builtin_amdgcn_mbcnt_lo(~0u, 0u)); asm volatile("" : "+v"(tid));
    const int lane = tid & 63, wave = tid >> 6;
    const int gw = blockIdx.x * 8 + wave, NGW = G * 8;
    const float* ss3 = (const float*)(wsl + WS_SS) + (size_t)3 * MTOK * 16;
    f32x4 g[4];
#pragma unroll
    for (int j = 0; j < 4; ++j) g[j] = ((const f32x4*)a.in[I_NF])[lane + 64 * j];
    for (int m = gw; m < MTOK; m += NGW) {
        f32x4* yr = (f32x4*)(a.out + OY + (size_t)m * DM);
        const u32x2* xr = (const u32x2*)((const bf16_t*)(wsl + WS_XA) + (size_t)m * DM);
        u32x2 xv[4];
#pragma unroll
        for (int j = 0; j < 4; ++j) xv[j] = xr[lane + 64 * j];
        const float rs = __builtin_amdgcn_rsqf(ss_row(ss3, (size_t)m, lane & 3, 1) * (1.0f / DM) + EPS);
#pragma unroll
        for (int j = 0; j < 4; ++j) { const f32x4 v = (f32x4){bflo(xv[j].x), bfhi(xv[j].x), bflo(xv[j].y), bfhi(xv[j].y)}; __builtin_nontemporal_store(v * rs * g[j], yr + lane + 64 * j); }
    }
}

constexpr int CV_TT = 32, CV_WIN = CV_TT + 30, CV_YOFF = CV_WIN * DC * 2, CV_YLD = DC + 4, CV_NITEMS = NB * (TP / CV_TT) + NB * (TS / CV_TT);
static_assert(CV_YOFF + CV_TT * CV_YLD * 4 <= LDS_BYTES, "conv LDS");
typedef float f32x2c __attribute__((ext_vector_type(2)));
__device__ __forceinline__ void conv_decode(int item, int& seq, int& t0, int& rowbase, bool& sample) {
    if (item < NB * (TP / CV_TT)) { seq = item / (TP / CV_TT); t0 = (item % (TP / CV_TT)) * CV_TT; rowbase = seq * TP; sample = false; }
    else { const int j = item - NB * (TP / CV_TT); seq = j / (TS / CV_TT); t0 = (j % (TS / CV_TT)) * CV_TT; rowbase = MP + seq * TS; sample = true; }
}
__device__ __forceinline__ void conv_load(u32x4 (&W)[8], const Args& a, int item, int tid) {
    unsigned char* const wsl = ws_reload();
    int seq, t0, rowbase; bool sample; conv_decode(item, seq, t0, rowbase, sample);
    const bf16_t* U = (const bf16_t*)(wsl + WS_U);
#pragma unroll
    for (int p = 0; p < 8; ++p) {
        const int idx = tid + 512 * p, i = idx >> 6, ch = (idx & 63) * 8, t = t0 - 30 + i;
        u32x4 v = (u32x4){0u, 0u, 0u, 0u};
        if (idx < CV_WIN * (DC / 8)) {
            if (t >= 0) v = *(const u32x4*)(U + (size_t)(rowbase + t) * DC + ch);
            else if (sample) { const float* s = a.in[I_SCONV] + ((size_t)(seq * 30 + 30 + t) * DC + ch); const f32x4 s0 = *(const f32x4*)s, s1 = *(const f32x4*)(s + 4);
                v.x = cvt_pk_bf16(s0.x, s0.y); v.y = cvt_pk_bf16(s0.z, s0.w); v.z = cvt_pk_bf16(s1.x, s1.y); v.w = cvt_pk_bf16(s1.z, s1.w); }
        }
        W[p] = v;
    }
}
__device__ __forceinline__ void conv_items(const Args& a, LAS unsigned char* lds, int first, int stride, const int wid0) {
    unsigned char* const wsl = ws_reload();
    int tid = wid0 * 64 + (int)__builtin_amdgcn_mbcnt_hi(~0u, __builtin_amdgcn_mbcnt_lo(~0u, 0u)); asm volatile("" : "+v"(tid));
    const int lane = tid & 63, wave = tid >> 6;
    if (first >= CV_NITEMS) return;
    bf16_t* CR = (bf16_t*)(wsl + WS_CR);
    const int cp = tid & 255, th = tid >> 8;
    f32x2c w2[CW];
#pragma unroll
    for (int j = 0; j < CW; ++j) w2[j] = *(const f32x2c*)(a.in[I_DWW] + j * DC + 2 * cp);
    const f32x2c bias2 = *(const f32x2c*)(a.in[I_DWB] + 2 * cp);
    const f32x4 g0 = *(const f32x4*)(a.in[I_LNG] + lane * 8), g1 = *(const f32x4*)(a.in[I_LNG] + lane * 8 + 4);
    const f32x4 b0 = *(const f32x4*)(a.in[I_LNB] + lane * 8), b1 = *(const f32x4*)(a.in[I_LNB] + lane * 8 + 4);
    u32x4 W[8];
    conv_load(W, a, first, tid);
    for (int item = first; item < CV_NITEMS; item += stride) {
        int seq, t0, rowbase; bool sample; conv_decode(item, seq, t0, rowbase, sample);
#pragma unroll
        for (int p = 0; p < 8; ++p) { const int idx = tid + 512 * p; if (idx < CV_WIN * (DC / 8)) *(LAS u32x4*)(lds + (size_t)idx * 16) = W[p]; }
        LBAR();
        if (item + stride < CV_NITEMS) conv_load(W, a, item + stride, tid);
        f32x2c acc[16];
#pragma unroll
        for (int t = 0; t < 16; ++t) acc[t] = bias2;
#pragma unroll
        for (int i = 0; i < 46; ++i) {
            const unsigned xw = *(const LAS unsigned*)(lds + ((th * 16 + i) * DC + 2 * cp) * 2);
            const f32x2c x2 = (f32x2c){bflo(xw), bfhi(xw)};
#pragma unroll
            for (int t = 0; t < 16; ++t) if (i - t >= 0 && i - t < CW) acc[t] = acc[t] + x2 * w2[i - t];
        }
        LAS float* yb = (LAS float*)(lds + CV_YOFF);
#pragma unroll
        for (int t = 0; t < 16; ++t) *(LAS f32x2c*)(yb + (th * 16 + t) * CV_YLD + 2 * cp) = acc[t];
        LBAR();
#pragma unroll
        for (int q = 0; q < 4; ++q) {
            const int tt = wave * 4 + q;
            const f32x4 y0 = *(const LAS f32x4*)(yb + tt * CV_YLD + lane * 8), y1 = *(const LAS f32x4*)(yb + tt * CV_YLD + lane * 8 + 4);
            const float mu = wave_sum((y0.x + y0.y) + (y0.z + y0.w) + (y1.x + y1.y) + (y1.z + y1.w)) * (1.0f / DC);
            const f32x4 d0 = y0 - mu, d1 = y1 - mu;
            const float var = wave_sum((d0.x * d0.x + d0.y * d0.y) + (d0.z * d0.z + d0.w * d0.w) + (d1.x * d1.x + d1.y * d1.y) + (d1.z * d1.z + d1.w * d1.w)) * (1.0f / DC);
            const float rs = __builtin_amdgcn_rsqf(var + EPS);
            const f32x4 z0 = d0 * rs * g0 + b0, z1 = d1 * rs * g1 + b1;
            u32x4 o; o.x = cvt_pk_bf16(siluf_(z0.x), siluf_(z0.y)); o.y = cvt_pk_bf16(siluf_(z0.z), siluf_(z0.w)); o.z = cvt_pk_bf16(siluf_(z1.x), siluf_(z1.y)); o.w = cvt_pk_bf16(siluf_(z1.z), siluf_(z1.w));
            *(u32x4*)(CR + (size_t)(rowbase + t0 + tt) * DM + lane * 8) = o;
        }
        LBAR();
    }
}

constexpr int SC_QS = 0, SC_QE = 17408, SC_KE = 34816, SC_KET = 52224, SC_VT = 70656, SC_P = 89088, SC_SEG = 98304, SC_DEC = 102400, SC_OB = 103424, SC_ENDB = SC_OB + 64 * 132 * 4;
constexpr int SC_LD = 272, SC_LDT = 144, SC_OLD = 132;
static_assert(SC_ENDB <= LDS_BYTES - 64, "scan LDS");
typedef float f32x2 __attribute__((ext_vector_type(2)));
struct ScanRaw { f32x2 lf[8]; unsigned q[8], k[8], v[8]; };
__device__ __forceinline__ void scan_load(ScanRaw& r, const float* LF, const bf16_t* Qb, const bf16_t* Kb, const bf16_t* Vb, size_t row0, int col) {
#pragma unroll
    for (int i = 0; i < 8; ++i) { const size_t o = (row0 + i) * DH + col; r.lf[i] = __builtin_nontemporal_load((const f32x2*)(LF + o)); r.q[i] = __builtin_nontemporal_load((const unsigned*)(Qb + o)); r.k[i] = __builtin_nontemporal_load((const unsigned*)(Kb + o)); r.v[i] = __builtin_nontemporal_load((const unsigned*)(Vb + o)); }
}
__device__ __forceinline__ void scan_item(const Args& a, LAS unsigned char* lds, bool sample, int seq, int h, const int wid0) {
    unsigned char* const wsl = ws_reload();
    int tid = wid0 * 64 + (int)__builtin_amdgcn_mbcnt_hi(~0u, __builtin_amdgcn_mbcnt_lo(~0u, 0u)); asm volatile("" : "+v"(tid));
    const int lane = tid & 63, w = __builtin_amdgcn_readfirstlane(tid >> 6), l15 = lane & 15, quad = lane >> 4;
    const int T = sample ? TS : TP, rowbase = sample ? MP + seq * TS : seq * TP, nchunk = T / 64;
    const bf16_t* Qb = (const bf16_t*)(wsl + WS_Q); const bf16_t* Kb = (const bf16_t*)(wsl + WS_K); const bf16_t* Vb = (const bf16_t*)(wsl + WS_V); const bf16_t* Gb = (const bf16_t*)(wsl + WS_G);
    const float* LF = (const float*)(wsl + WS_LF); bf16_t* CR = (bf16_t*)(wsl + WS_CR);
    const int kp = lane, seg = w, col = h * 128 + 2 * kp;
    f32x4 sacc[8];
    if (sample) { const float* s0 = a.in[I_SHGRN] + (size_t)(seq * 4 + h) * 128 * 128;
#pragma unroll
        for (int kb = 0; kb < 8; ++kb)
#pragma unroll
            for (int j = 0; j < 4; ++j) sacc[kb][j] = s0[(size_t)(16 * kb + 4 * quad + j) * 128 + 16 * w + l15];
    } else {
#pragma unroll
        for (int kb = 0; kb < 8; ++kb) sacc[kb] = (f32x4){0.f, 0.f, 0.f, 0.f};
    }
    LAS f32x2* segs = (LAS f32x2*)(lds + SC_SEG); LAS float* dec = (LAS float*)(lds + SC_DEC); LAS float* ob = (LAS float*)(lds + SC_OB);
    const int ot = tid >> 3, ov0 = (tid & 7) * 16;
    bool pend = false; size_t p_orow = 0; u32x4 p_g0 = (u32x4){0u, 0u, 0u, 0u}, p_g1 = p_g0;
    ScanRaw R;
    scan_load(R, LF, Qb, Kb, Vb, (size_t)rowbase + seg * 8, col);
    for (int c = 0; c < nchunk; ++c) {
        f32x2 cs[8]; f32x2 run = (f32x2){0.f, 0.f};
#pragma unroll
        for (int i = 0; i < 8; ++i) { run = run + R.lf[i]; cs[i] = run; }
        segs[seg * 64 + kp] = run;
        LBAR();
        if (pend) {
            const size_t orow = p_orow; const u32x4 gq0 = p_g0, gq1 = p_g1;
            {
                f32x4 o[4]; float sq = 0.f;
#pragma unroll
                for (int i = 0; i < 4; ++i) { o[i] = *(const LAS f32x4*)(ob + ot * SC_OLD + ov0 + 4 * i); sq += (o[i].x * o[i].x + o[i].y * o[i].y) + (o[i].z * o[i].z + o[i].w * o[i].w); }
                sq += __shfl_xor(sq, 1); sq += __shfl_xor(sq, 2); sq += __shfl_xor(sq, 4);
                const float rs = __builtin_amdgcn_rsqf(sq * (1.0f / 128.0f) + EPS);
                u32x4 r0v, r1v;
                r0v.x = cvt_pk_bf16(o[0].x * rs * bflo(gq0.x), o[0].y * rs * bfhi(gq0.x)); r0v.y = cvt_pk_bf16(o[0].z * rs * bflo(gq0.y), o[0].w * rs * bfhi(gq0.y));
                r0v.z = cvt_pk_bf16(o[1].x * rs * bflo(gq0.z), o[1].y * rs * bfhi(gq0.z)); r0v.w = cvt_pk_bf16(o[1].z * rs * bflo(gq0.w), o[1].w * rs * bfhi(gq0.w));
                r1v.x = cvt_pk_bf16(o[2].x * rs * bflo(gq1.x), o[2].y * rs * bfhi(gq1.x)); r1v.y = cvt_pk_bf16(o[2].z * rs * bflo(gq1.y), o[2].w * rs * bfhi(gq1.y));
                r1v.z = cvt_pk_bf16(o[3].x * rs * bflo(gq1.z), o[3].y * rs * bfhi(gq1.z)); r1v.w = cvt_pk_bf16(o[3].z * rs * bflo(gq1.w), o[3].w * rs * bfhi(gq1.w));
                bf16_t* dst = CR + orow * DM + DC + h * 128 + ov0;
                *(u32x4*)dst = r0v; *(u32x4*)(dst + 8) = r1v;
            }
        }
        f32x2 off = (f32x2){0.f, 0.f}, tot = (f32x2){0.f, 0.f};
#pragma unroll
        for (int s = 0; s < 8; ++s) { const f32x2 v = segs[s * 64 + kp]; if (s < seg) off = off + v; tot = tot + v; }
        const f32x2 etot = (f32x2){__expf(tot.x), __expf(tot.y)};
        if (seg == 0) *(LAS f32x2*)(dec + 2 * kp) = etot;
        unsigned ke0[4], ke1[4], v0[4], v1[4];
#pragma unroll
        for (int i = 0; i < 8; ++i) {
            const f32x2 b = off + cs[i];
            const float q0 = bflo(R.q[i]), q1 = bfhi(R.q[i]), k0 = bflo(R.k[i]), k1 = bfhi(R.k[i]);
            const float e0 = __expf(b.x), e1 = __expf(b.y);
            const float qs0 = q0 * e0, qs1 = q1 * e1;
            const unsigned pq = cvt_pk_bf16(qs0, qs1);
            const unsigned pk = cvt_pk_bf16(k0 * __builtin_amdgcn_rcpf(e0), k1 * __builtin_amdgcn_rcpf(e1));
            const int t = seg * 8 + i;
            *(LAS unsigned*)(lds + SC_QS + t * SC_LD + kp * 4) = pq;
            *(LAS unsigned*)(lds + SC_KE + t * SC_LD + kp * 4) = pk;
            if (i & 1) { ke0[i >> 1] |= pk << 16; ke1[i >> 1] |= pk & 0xffff0000u; v0[i >> 1] |= R.v[i] << 16; v1[i >> 1] |= R.v[i] & 0xffff0000u; }
            else { ke0[i >> 1] = pk & 0xffffu; ke1[i >> 1] = pk >> 16; v0[i >> 1] = R.v[i] & 0xffffu; v1[i >> 1] = R.v[i] >> 16; }
        }
        *(LAS u32x4*)(lds + SC_KET + (2 * kp) * SC_LDT + seg * 16) = (u32x4){ke0[0], ke0[1], ke0[2], ke0[3]};
        *(LAS u32x4*)(lds + SC_KET + (2 * kp + 1) * SC_LDT + seg * 16) = (u32x4){ke1[0], ke1[1], ke1[2], ke1[3]};
        *(LAS u32x4*)(lds + SC_VT + (2 * kp) * SC_LDT + seg * 16) = (u32x4){v0[0], v0[1], v0[2], v0[3]};
        *(LAS u32x4*)(lds + SC_VT + (2 * kp + 1) * SC_LDT + seg * 16) = (u32x4){v1[0], v1[1], v1[2], v1[3]};
        LBAR();
        if (c + 1 < nchunk) scan_load(R, LF, Qb, Kb, Vb, (size_t)rowbase + (c + 1) * 64 + seg * 8, col);
        {
            const int tb = w & 3;
#pragma unroll
            for (int sbi = 0; sbi < 2; ++sbi) {
                const int sb = (w >> 2) * 2 + sbi;
                f32x4 pacc = (f32x4){0.f, 0.f, 0.f, 0.f};
                if (sb <= tb) {
#pragma unroll
                    for (int kt = 0; kt < 4; ++kt) {
                        const bf16x8 af = *(const LAS bf16x8*)(lds + SC_KE + (16 * sb + l15) * SC_LD + (32 * kt + 8 * quad) * 2);
                        const bf16x8 bf = *(const LAS bf16x8*)(lds + SC_QS + (16 * tb + l15) * SC_LD + (32 * kt + 8 * quad) * 2);
                        pacc = __builtin_amdgcn_mfma_f32_16x16x32_bf16(af, bf, pacc, 0, 0, 0);
                    }
                    const int t = 16 * tb + l15, s = 16 * sb + 4 * quad;
#pragma unroll
                    for (int j = 0; j < 4; ++j) if (s + j > t) pacc[j] = 0.f;
                }
                u32x2 p; p.x = cvt_pk_bf16(pacc[0], pacc[1]); p.y = cvt_pk_bf16(pacc[2], pacc[3]);
                *(LAS u32x2*)(lds + SC_P + (16 * tb + l15) * SC_LDT + (16 * sb + 4 * quad) * 2) = p;
            }
        }
        f32x4 oacc[4];
#pragma unroll
        for (int tb = 0; tb < 4; ++tb) oacc[tb] = (f32x4){0.f, 0.f, 0.f, 0.f};
#pragma unroll
        for (int kt = 0; kt < 4; ++kt) {
            u32x4 ap; ap.x = cvt_pk_bf16(sacc[2 * kt][0], sacc[2 * kt][1]); ap.y = cvt_pk_bf16(sacc[2 * kt][2], sacc[2 * kt][3]);
            ap.z = cvt_pk_bf16(sacc[2 * kt + 1][0], sacc[2 * kt + 1][1]); ap.w = cvt_pk_bf16(sacc[2 * kt + 1][2], sacc[2 * kt + 1][3]);
            const bf16x8 af = __builtin_bit_cast(bf16x8, ap);
#pragma unroll
            for (int tb = 0; tb < 4; ++tb) {
                const u32x2 lo = *(const LAS u32x2*)(lds + SC_QS + (16 * tb + l15) * SC_LD + (32 * kt + 4 * quad) * 2);
                const u32x2 hi = *(const LAS u32x2*)(lds + SC_QS + (16 * tb + l15) * SC_LD + (32 * kt + 16 + 4 * quad) * 2);
                const bf16x8 bf = __builtin_bit_cast(bf16x8, (u32x4){lo.x, lo.y, hi.x, hi.y});
                oacc[tb] = __builtin_amdgcn_mfma_f32_16x16x32_bf16(af, bf, oacc[tb], 0, 0, 0);
            }
        }
        const size_t orow = (size_t)rowbase + c * 64 + ot;
        const u32x4 gq0 = __builtin_nontemporal_load((const u32x4*)(Gb + orow * DH + h * 128 + ov0)), gq1 = __builtin_nontemporal_load((const u32x4*)(Gb + orow * DH + h * 128 + ov0 + 8));
        LBAR();
        bf16x8 vf[2];
#pragma unroll
        for (int st = 0; st < 2; ++st) vf[st] = *(const LAS bf16x8*)(lds + SC_VT + (16 * w + l15) * SC_LDT + (32 * st + 8 * quad) * 2);
#pragma unroll
        for (int tb = 0; tb < 4; ++tb)
#pragma unroll
            for (int st = 0; st < 2; ++st) {
                const bf16x8 bf = *(const LAS bf16x8*)(lds + SC_P + (16 * tb + l15) * SC_LDT + (32 * st + 8 * quad) * 2);
                oacc[tb] = __builtin_amdgcn_mfma_f32_16x16x32_bf16(vf[st], bf, oacc[tb], 0, 0, 0);
            }
#pragma unroll
        for (int tb = 0; tb < 4; ++tb) *(LAS f32x4*)(ob + (16 * tb + l15) * SC_OLD + 16 * w + 4 * quad) = oacc[tb];
#pragma unroll
        for (int kb = 0; kb < 8; ++kb) {
            const f32x4 d = *(const LAS f32x4*)(dec + 16 * kb + 4 * quad);
#pragma unroll
            for (int st = 0; st < 2; ++st) {
                const bf16x8 af = *(const LAS bf16x8*)(lds + SC_KET + (16 * kb + l15) * SC_LDT + (32 * st + 8 * quad) * 2);
                sacc[kb] = __builtin_amdgcn_mfma_f32_16x16x32_bf16(af, vf[st], sacc[kb], 0, 0, 0);
            }
            sacc[kb] = sacc[kb] * d;
        }
        pend = true; p_orow = orow; p_g0 = gq0; p_g1 = gq1;
    }
    LBAR();
    {
        const size_t orow = p_orow; const u32x4 gq0 = p_g0, gq1 = p_g1;
    {
        f32x4 o[4]; float sq = 0.f;
#pragma unroll
        for (int i = 0; i < 4; ++i) { o[i] = *(const LAS f32x4*)(ob + ot * SC_OLD + ov0 + 4 * i); sq += (o[i].x * o[i].x + o[i].y * o[i].y) + (o[i].z * o[i].z + o[i].w * o[i].w); }
        sq += __shfl_xor(sq, 1); sq += __shfl_xor(sq, 2); sq += __shfl_xor(sq, 4);
        const float rs = __builtin_amdgcn_rsqf(sq * (1.0f / 128.0f) + EPS);
        u32x4 r0v, r1v;
        r0v.x = cvt_pk_bf16(o[0].x * rs * bflo(gq0.x), o[0].y * rs * bfhi(gq0.x)); r0v.y = cvt_pk_bf16(o[0].z * rs * bflo(gq0.y), o[0].w * rs * bfhi(gq0.y));
        r0v.z = cvt_pk_bf16(o[1].x * rs * bflo(gq0.z), o[1].y * rs * bfhi(gq0.z)); r0v.w = cvt_pk_bf16(o[1].z * rs * bflo(gq0.w), o[1].w * rs * bfhi(gq0.w));
        r1v.x = cvt_pk_bf16(o[2].x * rs * bflo(gq1.x), o[2].y * rs * bfhi(gq1.x)); r1v.y = cvt_pk_bf16(o[2].z * rs * bflo(gq1.y), o[2].w * rs * bfhi(gq1.y));
        r1v.z = cvt_pk_bf16(o[3].x * rs * bflo(gq1.z), o[3].y * rs * bfhi(gq1.z)); r1v.w = cvt_pk_bf16(o[3].z * rs * bflo(gq1.w), o[3].w * rs * bfhi(gq1.w));
        bf16_t* dst = CR + orow * DM + DC + h * 128 + ov0;
        *(u32x4*)dst = r0v; *(u32x4*)(dst + 8) = r1v;
    }
    }
    float* so = a.out + (sample ? OHS : OHP) + (size_t)(seq * 4 + h) * 128 * 128;
#pragma unroll
    for (int kb = 0; kb < 8; ++kb)
#pragma unroll
        for (int j = 0; j < 4; ++j) so[(size_t)(16 * kb + 4 * quad + j) * 128 + 16 * w + l15] = sacc[kb][j];
    LBAR();
}

__device__ __forceinline__ void small_resid_gemm(const Args& a, LAS unsigned char* lds, int ph, const int wid0) {
    unsigned char* const wsl = ws_reload();
    int tid = wid0 * 64 + (int)__builtin_amdgcn_mbcnt_hi(~0u, __builtin_amdgcn_mbcnt_lo(~0u, 0u)); asm volatile("" : "+v"(tid));
    const int lane = tid & 63, w = __builtin_amdgcn_readfirstlane(tid >> 6), l15 = lane & 15, quad = lane >> 4;
    const int b = blockIdx.x; if (b >= 256) return;
    const int rb = b >> 4, cb = b & 15;
    const int K = (ph == 5) ? DM : FF, nblk = K / 64;
    const bf16_t* A = (const bf16_t*)(wsl + (ph == 5 ? WS_CR : WS_H)) + (size_t)(MP + 64 * rb + l15) * K + 16 * quad;
    const bf16_t* B = (const bf16_t*)(wsl + (ph == 2 ? WS_W2A : ph == 5 ? WS_WOUT : WS_W2B)) + (size_t)(64 * cb + l15) * K + 16 * quad;
    f32x4 acc[4][4];
#pragma unroll
    for (int rt = 0; rt < 4; ++rt)
#pragma unroll
        for (int ct = 0; ct < 4; ++ct) acc[rt][ct] = (f32x4){0.f, 0.f, 0.f, 0.f};
    for (int blk0 = w; blk0 < nblk; blk0 += 16) {
        bf16x8 af[2][2][4], bf[2][2][4];
#pragma unroll
        for (int q = 0; q < 2; ++q) { const int blk = blk0 + 8 * q; if (blk < nblk) {
#pragma unroll
            for (int h = 0; h < 2; ++h)
#pragma unroll
                for (int t = 0; t < 4; ++t) { af[q][h][t] = *(const bf16x8*)(A + (size_t)(16 * t) * K + blk * 64 + 8 * h); bf[q][h][t] = *(const bf16x8*)(B + (size_t)(16 * t) * K + blk * 64 + 8 * h); } } }
#pragma unroll
        for (int q = 0; q < 2; ++q) { const int blk = blk0 + 8 * q; if (blk < nblk) {
#pragma unroll
            for (int h = 0; h < 2; ++h)
#pragma unroll
                for (int rt = 0; rt < 4; ++rt)
#pragma unroll
                    for (int ct = 0; ct < 4; ++ct) acc[rt][ct] = __builtin_amdgcn_mfma_f32_16x16x32_bf16(bf[q][h][ct], af[q][h][rt], acc[rt][ct], 0, 0, 0); } }
    }
    constexpr int PP = 68;
    LAS float* part = (LAS float*)(lds + (size_t)w * (64 * PP * 4));
#pragma unroll
    for (int rt = 0; rt < 4; ++rt)
#pragma unroll
        for (int ct = 0; ct < 4; ++ct) *(LAS f32x4*)(part + (16 * rt + l15) * PP + 16 * ct + 4 * quad) = acc[rt][ct];
    LBAR();
    const int r = tid >> 3, c8 = (tid & 7) * 8;
    f32x4 o0 = (f32x4){0.f, 0.f, 0.f, 0.f}, o1 = o0;
#pragma unroll
    for (int ww = 0; ww < 8; ++ww) { const LAS float* p = (const LAS float*)(lds + (size_t)ww * (64 * PP * 4)) + r * PP + c8; o0 = o0 + *(const LAS f32x4*)p; o1 = o1 + *(const LAS f32x4*)(p + 4); }
    const size_t grow = (size_t)MP + 64 * rb + r;
    const int col = 64 * cb + c8;
    bf16_t* xa = (bf16_t*)(wsl + WS_XA);
    const float scale = (ph == 5) ? 1.0f : 0.5f;
    f32x4 b0, b1;
    if (ph == 2 && !MK_XABASE) { const float* xs = a.in[I_XS] + (grow - MP) * DM + col; b0 = *(const f32x4*)xs; b1 = *(const f32x4*)(xs + 4); }
    else { const u32x4 rr = *(const u32x4*)(xa + grow * DM + col); b0 = (f32x4){bflo(rr.x), bfhi(rr.x), bflo(rr.y), bfhi(rr.y)}; b1 = (f32x4){bflo(rr.z), bfhi(rr.z), bflo(rr.w), bfhi(rr.w)}; }
    o0 = b0 + o0 * scale; o1 = b1 + o1 * scale;
    u32x4 wv; wv.x = cvt_pk_bf16(o0[0], o0[1]); wv.y = cvt_pk_bf16(o0[2], o0[3]); wv.z = cvt_pk_bf16(o1[0], o1[1]); wv.w = cvt_pk_bf16(o1[2], o1[3]);
    *(u32x4*)(xa + grow * DM + col) = wv;
    float s = ((o0[0] * o0[0] + o0[1] * o0[1]) + (o0[2] * o0[2] + o0[3] * o0[3])) + ((o1[0] * o1[0] + o1[1] * o1[1]) + (o1[2] * o1[2] + o1[3] * o1[3]));
    s += __shfl_xor(s, 1); s += __shfl_xor(s, 2); s += __shfl_xor(s, 4);
    if ((tid & 7) == 0) { float* ss_out = (float*)(wsl + WS_SS) + (size_t)(ph == 2 ? 1 : (ph == 5 ? 2 : 3)) * MTOK * 16; ss_out[grow * 16 + cb] = s; }
    LBAR();
}

#define XB_TMO      128
#define XB_XCNT(j)  (256  + 64 * (j))
#define XB_XSUB(j)  (1280 + 64 * (j))
#define XB_XGEN(j)  (2304 + 64 * (j))
#define XB_TOP      3328
#define XB_TOPGEN   3392
#define XCD_BAR_WORDS 3456
#define XB_SPIN_CAP (1u << 18)

__device__ __forceinline__ unsigned xb_ld(unsigned* p)              { return __hip_atomic_load(p, __ATOMIC_RELAXED, __HIP_MEMORY_SCOPE_AGENT); }
__device__ __forceinline__ unsigned xb_add(unsigned* p, unsigned v) { return __hip_atomic_fetch_add(p, v, __ATOMIC_RELAXED, __HIP_MEMORY_SCOPE_AGENT); }
__device__ __forceinline__ unsigned xb_xcc_id() { return (unsigned)__builtin_amdgcn_s_getreg((3 << 11) | 20) & 0xFu; }
#define XB_SPIN(cond, bar) do { unsigned _sp = 0; while (cond) { __builtin_amdgcn_s_sleep(1); \
    if ((++_sp & 255u) == 0u) { if (xb_ld(&(bar)[XB_TMO])) break; if (_sp > XB_SPIN_CAP) { atomicAdd(&(bar)[XB_TMO], 1u); break; } } } } while (0)

struct XcdBarrier {
    unsigned total;
    unsigned* bar; unsigned x;
    volatile LAS unsigned* st;
};

__device__ __forceinline__ XcdBarrier xcd_barrier_post(unsigned* bar, volatile LAS unsigned* st, bool t0, unsigned total) {
    XcdBarrier b; b.total = total; b.bar = bar; b.x = xb_xcc_id(); b.st = st;
    if (t0) (void)xb_add(&bar[XB_XCNT(b.x)], 1u);
    return b;
}
__device__ __forceinline__ void xcd_barrier_complete(unsigned* bar, unsigned x, unsigned& nloc, unsigned& nx, const unsigned G) {
    unsigned sum, cnt, mine, sp = 0u;
    for (;;) {
        sum = 0u; cnt = 0u; mine = 0u;
#pragma unroll
        for (unsigned j = 0; j < 16; ++j) { const unsigned c = xb_ld(&bar[XB_XCNT(j)]); sum += c; cnt += (c > 0u) ? 1u : 0u; mine = (j == x) ? c : mine; }
        if (sum == G) break;
        __builtin_amdgcn_s_sleep(1);
        if ((++sp & 255u) == 0u) { if (xb_ld(&bar[XB_TMO])) break; if (sp > XB_SPIN_CAP) { atomicAdd(&bar[XB_TMO], 1u); break; } }
    }
    nloc = mine > 0u ? mine : 1u; nx = cnt > 0u ? cnt : 1u;
}

__device__ __forceinline__ void xcd_barrier(const XcdBarrier& b, const int wid0) {
    const bool t0 = (wid0 == 0) && (__builtin_amdgcn_mbcnt_hi(~0u, __builtin_amdgcn_mbcnt_lo(~0u, 0u)) == 0u);
    asm volatile("s_waitcnt vmcnt(0)" ::: "memory");
    __syncthreads();
    if (t0) {
        unsigned* bar = b.bar;
        __builtin_amdgcn_s_waitcnt(0);
        unsigned nloc = b.st[0], nx = b.st[1];
        if (nloc == 0u) { xcd_barrier_complete(bar, b.x, nloc, nx, b.total); b.st[0] = nloc; b.st[1] = nx; }
        const unsigned old = xb_add(&bar[XB_XSUB(b.x)], 1u);
        const unsigned gen = old / nloc;
        if (old + 1u == (gen + 1u) * nloc) {
            __builtin_amdgcn_fence(__ATOMIC_RELEASE, "agent");
            asm volatile("s_waitcnt vmcnt(0)" ::: "memory");
            const unsigned og = xb_add(&bar[XB_TOP], 1u);
            const unsigned tg = og / nx;
            if (og + 1u == (tg + 1u) * nx) xb_add(&bar[XB_TOPGEN], 1u);
            else XB_SPIN(xb_ld(&bar[XB_TOPGEN]) == tg, bar);
            __builtin_amdgcn_fence(__ATOMIC_ACQUIRE, "agent");
            xb_add(&bar[XB_XGEN(b.x)], 1u);
            asm volatile("s_waitcnt vmcnt(0)" ::: "memory");
        } else {
            XB_SPIN(xb_ld(&bar[XB_XGEN(b.x)]) == gen, bar);
            __builtin_amdgcn_fence(__ATOMIC_ACQUIRE, "agent");
            asm volatile("s_waitcnt vmcnt(0)" ::: "memory");
        }
    }
    __syncthreads();
}


__global__ void __launch_bounds__(512, 2) fwd_megakernel(Args a) {
    extern __shared__ __attribute__((aligned(16))) unsigned char lds_raw[];
    LAS unsigned char* lds = (LAS unsigned char*)lds_raw;
    cg::grid_group grid = cg::this_grid();
    const int G = gridDim.x;
    const int wid0 = __builtin_amdgcn_readfirstlane((int)threadIdx.x >> 6);
    volatile LAS unsigned* bst = (volatile LAS unsigned*)(lds + LDS_BYTES - 64);
    if (threadIdx.x < 4) bst[threadIdx.x] = 0u;
    const bool thr0 = threadIdx.x == 0;
    __syncthreads();
    grid.sync();
    XcdBarrier xbar = xcd_barrier_post((unsigned*)(a.ws + WS_BAR), bst, thr0, (unsigned)G);
    XcdBarrier xbar2 = xbar;
    if (blockIdx.x >= 64) xbar2 = xcd_barrier_post((unsigned*)(a.ws + WS_BAR + 16384), bst + 2, thr0, (unsigned)(G - 64));
    for (int pi = a.ph_lo; pi < a.ph_hi; ++pi) {
        unsigned char* ws = ws_reload();
        const int ph = (MK_DUP >= 0 && pi > MK_DUP) ? pi - 1 : pi;
        if (ph == 0) { p0_weights(a, lds, 0, 1408, (int)blockIdx.x * 8 + wid0, G * 8, wid0); p0_rows(a, G, wid0); }
        else if (ph == 4) {
            const int b = blockIdx.x;
            if (b < 64) scan_item(a, lds, false, b >> 2, b & 3, wid0);
            else {
                pg8::Gemm g{(const bf16_t*)(ws + WS_XA), (const bf16_t*)(ws + WS_WIN), MTOK, DM, DM};
                pg8::Epi E{2, 1, 3, 0, 0};
                pg8::StaticOrder S; S.init(g.M, g.N, G - 64, b - 64);
                pg8::gemm_phase(a, lds, g, S, E, wid0);
                pg8::Gemm g2{(const bf16_t*)(ws + WS_XA) + (size_t)MP * DM, (const bf16_t*)(ws + WS_WIN) + (size_t)4 * 256 * DM, MS, DIN - 4 * 256, DM};
                pg8::Epi E2{2, 1, 3, 4, MP / 256};
                pg8::StaticOrder S2; S2.init(g2.M, g2.N, G - 64, b - 64);
                pg8::gemm_phase(a, lds, g2, S2, E2, wid0);
                xcd_barrier(xbar2, wid0);
                if (b < 128) scan_item(a, lds, true, (b - 64) >> 2, b & 3, wid0);
                conv_items(a, lds, b - 64, G - 64, wid0);
            }
        }
        else if (ph == 8) p8_final(a, G, wid0);
        else {
            const bool up = (ph == 1 || ph == 6), down = (ph == 2 || ph == 7);
            const size_t aoff = down ? WS_H : (ph == 5 ? WS_CR : WS_XA);
            const size_t boff = ph == 1 ? WS_W13A : ph == 2 ? WS_W2A : ph == 3 ? WS_WIN : ph == 5 ? WS_WOUT : ph == 6 ? WS_W13B : WS_W2B;
            const bool resid = down || ph == 5;
            pg8::Gemm g{(const bf16_t*)(ws + aoff), (const bf16_t*)(ws + boff + (ph == 3 ? (size_t)4 * 256 * DM * 2 : 0)), (resid || ph == 3) ? MP : MTOK, up ? 2 * FF : (ph == 3 ? DIN - 4 * 256 : DM), down ? FF : DM};
            pg8::Epi E{up ? 0 : (ph == 3 ? 2 : 1), 1, ph, ph == 3 ? 4 : 0, 0};
            pg8::StaticOrder S; S.init(g.M, g.N, G, (int)blockIdx.x);
            pg8::gemm_phase(a, lds, g, S, E, wid0);
            if (ph == 1 && G == 256 && (int)blockIdx.x >= 88) p0_weights(a, lds, 1408, 5248, ((int)blockIdx.x - 88) * 8 + wid0, 168 * 8, wid0);
            if (ph == 1 && G != 256 && blockIdx.x == 0) p0_weights(a, lds, 1408, 5248, wid0, 8, wid0);
            if (resid) small_resid_gemm(a, lds, ph, wid0);
        }
        if (pi + 1 < a.ph_hi) xcd_barrier(xbar, wid0);
    }
}

extern "C" void kernel_launch(void* const* d_in, const int* in_sizes, int n_in, void* d_out, int out_size, void* d_ws, size_t ws_size, hipStream_t stream) {
    static int grid = 0;
    if (grid == 0) {
        if (n_in != 22 || ws_size < WS_END) { fprintf(stderr, "kernel_launch: unexpected n_in %d / ws %zu\n", n_in, ws_size); grid = -1; return; }
        int dev = 0, cus = 0, per_cu = 0;
        hipGetDevice(&dev); hipDeviceGetAttribute(&cus, hipDeviceAttributeMultiprocessorCount, dev);
        if (hipFuncSetAttribute((const void*)fwd_megakernel, hipFuncAttributeMaxDynamicSharedMemorySize, LDS_BYTES) != hipSuccess) { fprintf(stderr, "kernel_launch: hipFuncSetAttribute failed\n"); grid = -1; return; }
        if (hipOccupancyMaxActiveBlocksPerMultiprocessor(&per_cu, (const void*)fwd_megakernel, 512, LDS_BYTES) != hipSuccess || per_cu < 1) { fprintf(stderr, "kernel_launch: occupancy query says %d\n", per_cu); per_cu = 1; }
        (void)hipGetLastError();
        grid = cus * per_cu;
        fprintf(stderr, "kernel_launch: grid %d (cus %d x %d)\n", grid, cus, per_cu);
        if (grid < 256) { fprintf(stderr, "kernel_launch: this kernel needs at least 256 co-resident workgroups (64x64 sample tiles, scan items); nothing launched\n"); grid = -1; return; }
    }
    if (grid < 0) return;
    Args a{};
    for (int i = 0; i < 22; ++i) a.in[i] = (const float*)d_in[i];
    a.out = (float*)d_out; a.ws = (unsigned char*)d_ws;
    if (hipMemsetAsync((char*)d_ws + WS_BAR, 0, 32768, stream) != hipSuccess) { fprintf(stderr, "kernel_launch: memset of the barrier words failed\n"); return; }
    a.ph_lo = 0; a.ph_hi = 9 + (MK_DUP >= 0 ? 1 : 0);
    void* args[] = {&a};
    hipError_t e = hipLaunchCooperativeKernel((const void*)fwd_megakernel, dim3(grid), dim3(512), args, LDS_BYTES, stream);
    if (e != hipSuccess) fprintf(stderr, "cooperative launch failed: %s (grid %d)\n", hipGetErrorString(e), grid);
}
```
